# Optimizing an MI355X kernel written in HIP

```python
import math
import jax, jax.numpy as jnp
from jax import lax
import numpy as np

D_MODEL = 1024
BATCH = 8
SEQ = 8192
DEPTH = 1

EPS = 1e-6
HEAD_DIM = 64
N_Q_HEADS = D_MODEL // 64
N_KV_HEADS = max(1, N_Q_HEADS // 8)
GROUP = N_Q_HEADS // N_KV_HEADS
WINDOW = 128
BLOCK = 128
RET_HEADS = D_MODEL // 256
RET_QK_DIM = 256
RET_V_DIM = 512
RET_CHUNK = 128
RET_ROT_BASE = 10000.0
D_FF = ((-(-8 * D_MODEL // 3) + 255) // 256) * 256

ATT_Q = N_Q_HEADS * HEAD_DIM
ATT_KV = N_KV_HEADS * HEAD_DIM
RET_QK = RET_HEADS * RET_QK_DIM
RET_V = RET_HEADS * RET_V_DIM
IN_SPLITS = (ATT_Q, ATT_KV, ATT_KV, RET_QK, RET_QK, RET_V, RET_V, D_MODEL, D_MODEL)
D_IN = sum(IN_SPLITS)

kernel_name = "hybrid_swa_sink_retention_gated_block"


def rmsnorm(x, gain):
    xf = x.astype(jnp.float32)
    xf = xf * lax.rsqrt(jnp.mean(xf * xf, axis=-1, keepdims=True) + EPS)
    return (xf * gain.astype(jnp.float32)).astype(x.dtype)


def rms_group_norm(x):
    xf = x.astype(jnp.float32)
    return xf * lax.rsqrt(jnp.mean(xf * xf, axis=-1, keepdims=True) + EPS)


def sliding_window_attention(q, k, v, q_gain, k_gain, sinks):
    b, s, _, _ = q.shape
    nb = s // BLOCK
    q = rmsnorm(q, q_gain)
    k = rmsnorm(k, k_gain)
    qb = q.reshape(b, nb, BLOCK, N_KV_HEADS, GROUP, HEAD_DIM)
    kb = k.reshape(b, nb, BLOCK, N_KV_HEADS, HEAD_DIM)
    vb = v.reshape(b, nb, BLOCK, N_KV_HEADS, HEAD_DIM)
    pad = ((0, 0), (1, 0), (0, 0), (0, 0), (0, 0))
    k_band = jnp.concatenate([jnp.pad(kb, pad)[:, :-1], kb], axis=2)
    v_band = jnp.concatenate([jnp.pad(vb, pad)[:, :-1], vb], axis=2)
    scores = jnp.einsum('bnqkgd,bnskd->bnkgqs', qb, k_band).astype(jnp.float32) * (HEAD_DIM ** -0.5)
    blk = jnp.arange(nb)[:, None, None]
    q_pos = blk * BLOCK + jnp.arange(BLOCK)[None, :, None]
    k_pos = blk * BLOCK - BLOCK + jnp.arange(2 * BLOCK)[None, None, :]
    allowed = (k_pos <= q_pos) & (k_pos > q_pos - WINDOW) & (k_pos >= 0)
    scores = jnp.where(allowed[None, :, None, None], scores, -jnp.inf)
    sink = sinks.astype(jnp.float32).reshape(N_KV_HEADS, GROUP)[None, None, :, :, None, None]
    sink = jnp.broadcast_to(sink, scores.shape[:-1] + (1,))
    probs = jax.nn.softmax(jnp.concatenate([scores, sink], axis=-1), axis=-1)[..., :-1]
    out = jnp.einsum('bnkgqs,bnskd->bnqkgd', probs.astype(v.dtype), v_band)
    return out.reshape(b, s, N_Q_HEADS * HEAD_DIM)


def rotate_every_two(x):
    x1 = x[..., 0::2]
    x2 = x[..., 1::2]
    return jnp.stack((-x2, x1), axis=-1).reshape(x.shape)


def retention_chunkwise(q, k, v):
    b, s, _, _ = q.shape
    n = s // RET_CHUNK
    q = q.astype(jnp.float32)
    k = k.astype(jnp.float32) * (RET_QK_DIM ** -0.5)
    v = v.astype(jnp.float32)
    pos = jnp.arange(s, dtype=jnp.float32)
    theta = 1.0 / (RET_ROT_BASE ** jnp.linspace(0.0, 1.0, RET_QK_DIM // 2, dtype=jnp.float32))
    ang = jnp.repeat(pos[:, None] * theta[None, :], 2, axis=-1)[None, :, None, :]
    cos, sin = jnp.cos(ang), jnp.sin(ang)
    q = q * cos + rotate_every_two(q) * sin
    k = k * cos + rotate_every_two(k) * sin
    log_gamma = jnp.log(1.0 - 2.0 ** (-5.0 - jnp.arange(RET_HEADS, dtype=jnp.float32)))
    i = jnp.arange(RET_CHUNK, dtype=jnp.float32)
    diff = i[:, None] - i[None, :]
    causal = diff >= 0
    decay_inner = jnp.where(causal[None], jnp.exp(jnp.where(causal, diff, 0.0)[None] * log_gamma[:, None, None]), 0.0)
    xi = jnp.exp((i + 1.0)[None, :] * log_gamma[:, None])
    zeta = jnp.exp((RET_CHUNK - 1.0 - i)[None, :] * log_gamma[:, None])
    gamma_chunk = jnp.exp(RET_CHUNK * log_gamma)

    def to_chunks(t):
        return t.reshape(b, n, RET_CHUNK, RET_HEADS, t.shape[-1]).transpose(1, 0, 3, 2, 4)

    def step(state, qkv):
        qc, kc, vc = qkv
        inner = jnp.einsum('bhid,bhjd->bhij', qc, kc) * decay_inner
        out = jnp.einsum('bhij,bhjv->bhiv', inner, vc)
        out = out + jnp.einsum('bhid,bhdv->bhiv', qc, state) * xi[None, :, :, None]
        state = gamma_chunk[None, :, None, None] * state + jnp.einsum('bhjd,bhjv->bhdv', kc * zeta[None, :, :, None], vc)
        return state, out

    state0 = jnp.zeros((b, RET_HEADS, RET_QK_DIM, RET_V_DIM), jnp.float32)
    _, out = lax.scan(step, state0, (to_chunks(q), to_chunks(k), to_chunks(v)))
    return out.transpose(1, 0, 3, 2, 4).reshape(b, s, RET_HEADS, RET_V_DIM)


def setup_inputs(seed: int = 0) -> dict:
    key = jax.random.key(seed)
    ks = jax.random.split(key, 14)
    L = DEPTH
    nrm = lambda k, shape, fan_in: jax.random.normal(k, shape, jnp.float32) * (fan_in ** -0.5)
    gain = lambda k, shape: 1.0 + 0.02 * jax.random.normal(k, shape, jnp.float32)
    return {
        "x": jax.random.normal(ks[0], (BATCH, SEQ, D_MODEL), jnp.float32),
        "norm_mix_gain": gain(ks[1], (L, D_MODEL)),
        "w_in": nrm(ks[2], (L, D_MODEL, D_IN), D_MODEL),
        "q_norm_gain": gain(ks[3], (L, HEAD_DIM)),
        "k_norm_gain": gain(ks[4], (L, HEAD_DIM)),
        "attn_sinks": 0.5 * jax.random.normal(ks[5], (L, N_Q_HEADS), jnp.float32),
        "w_branch_attn": nrm(ks[6], (L, ATT_Q, D_MODEL), ATT_Q),
        "w_branch_ret": nrm(ks[7], (L, RET_V, D_MODEL), RET_V),
        "w_out": nrm(ks[8], (L, D_MODEL, D_MODEL), D_MODEL),
        "norm_ffn_gain": gain(ks[9], (L, D_MODEL)),
        "w_ffn_gate": nrm(ks[10], (L, D_MODEL, D_FF), D_MODEL),
        "w_ffn_up": nrm(ks[11], (L, D_MODEL, D_FF), D_MODEL),
        "w_ffn_down": nrm(ks[12], (L, D_FF, D_MODEL), D_FF),
    }


def reference(x, norm_mix_gain, w_in, q_norm_gain, k_norm_gain, attn_sinks, w_branch_attn, w_branch_ret, w_out, norm_ffn_gain, w_ffn_gate, w_ffn_up, w_ffn_down):
    b, s, _ = x.shape
    split_points = list(np.cumsum(IN_SPLITS)[:-1])
    for l in range(DEPTH):
        h = rmsnorm(x, norm_mix_gain[l])
        proj = jnp.einsum('bsd,de->bse', h, w_in[l])
        q_a, k_a, v_a, q_r, k_r, v_r, g_r, z_a, z_r = jnp.split(proj, split_points, axis=-1)
        attn = sliding_window_attention(
            q_a.reshape(b, s, N_Q_HEADS, HEAD_DIM),
            k_a.reshape(b, s, N_KV_HEADS, HEAD_DIM),
            v_a.reshape(b, s, N_KV_HEADS, HEAD_DIM),
            q_norm_gain[l], k_norm_gain[l], attn_sinks[l])
        ret = retention_chunkwise(
            q_r.reshape(b, s, RET_HEADS, RET_QK_DIM),
            k_r.reshape(b, s, RET_HEADS, RET_QK_DIM),
            v_r.reshape(b, s, RET_HEADS, RET_V_DIM))
        ret = (jax.nn.silu(g_r.astype(jnp.float32)) * rms_group_norm(ret).reshape(b, s, RET_V)).astype(x.dtype)
        branch_a = jnp.einsum('bse,ed->bsd', attn, w_branch_attn[l])
        branch_r = jnp.einsum('bse,ed->bsd', ret, w_branch_ret[l])
        merged = jax.nn.sigmoid(z_a) * branch_a + jax.nn.sigmoid(z_r) * branch_r
        x = x + jnp.einsum('bsd,de->bse', merged, w_out[l])
        h = rmsnorm(x, norm_ffn_gain[l])
        gate = jnp.einsum('bsd,df->bsf', h, w_ffn_gate[l])
        up = jnp.einsum('bsd,df->bsf', h, w_ffn_up[l])
        x = x + jnp.einsum('bsf,fd->bsd', jax.nn.silu(gate) * up, w_ffn_down[l])
    return x
```

```cpp
#include <hip/hip_runtime.h>
#include <hip/hip_cooperative_groups.h>
#include <cstdio>
#include <cstdint>
namespace cg = cooperative_groups;

#define LAS __attribute__((address_space(3)))
typedef unsigned short bf16_t;
typedef short bf16x8 __attribute__((ext_vector_type(8)));
typedef short s16x4 __attribute__((ext_vector_type(4)));
typedef float f32x4 __attribute__((ext_vector_type(4)));
typedef float f32x2 __attribute__((ext_vector_type(2)));
typedef unsigned u32x4 __attribute__((ext_vector_type(4)));
typedef unsigned u32x2 __attribute__((ext_vector_type(2)));
typedef __bf16 bf16x2_t __attribute__((ext_vector_type(2)));

constexpr int M_TOK = 65536, SEQ = 8192, DM = 1024, DIN = 9472, DFF = 2816;
constexpr int N_IN1 = 7424;
constexpr float EPS = 1e-6f;
constexpr float LOG2E = 1.4426950408889634f;

constexpr size_t MiB = 1u << 20;
constexpr size_t WS_QA = 0, WS_KVA = 128 * MiB, WS_QR = 160 * MiB, WS_KR = 288 * MiB, WS_VR = 416 * MiB, WS_GR = 672 * MiB;
constexpr size_t WS_WIN = 928 * MiB, WS_WBA = 947 * MiB, WS_WBR = 949 * MiB, WS_WOUT = 953 * MiB, WS_WGU = 955 * MiB, WS_WD = 966 * MiB;
constexpr size_t WS_SS = 972 * MiB, WS_SS2 = 973 * MiB, WS_END = 974 * MiB;
constexpr size_t WS_SZ = WS_QR, WS_X1 = WS_GR, WS_XN2 = WS_QA, WS_H = WS_QR;
constexpr size_t OUT_XN = 0, OUT_BA = 128 * MiB;

constexpr int LDS_BYTES = 135168;

__device__ __forceinline__ unsigned pkbf(float lo, float hi) { f32x2 v = {lo, hi}; bf16x2_t b = __builtin_convertvector(v, bf16x2_t); return __builtin_bit_cast(unsigned, b); }
__device__ __forceinline__ float bflo(unsigned u) { return __uint_as_float(u << 16); }
__device__ __forceinline__ float bfhi(unsigned u) { return __uint_as_float(u & 0xffff0000u); }
__device__ __forceinline__ float fexp2(float x) { return __builtin_amdgcn_exp2f(x); }
__device__ __forceinline__ float frcp(float x) { return __builtin_amdgcn_rcpf(x); }
__device__ __forceinline__ float sigmoidf_(float x) { return frcp(1.f + fexp2(-x * LOG2E)); }
__device__ __forceinline__ float siluf_(float x) { return x * sigmoidf_(x); }
__device__ __forceinline__ float wave_sum(float v) {
#pragma unroll
    for (int o = 1; o < 64; o <<= 1) v += __shfl_xor(v, o);
    return v;
}
__device__ __forceinline__ f32x4 mfma16(bf16x8 a, bf16x8 b, f32x4 c) { return __builtin_amdgcn_mfma_f32_16x16x32_bf16(a, b, c, 0, 0, 0); }
__device__ __forceinline__ s16x4 ldstr(LAS unsigned char* p) { return __builtin_bit_cast(s16x4, __builtin_amdgcn_ds_read_tr16_b64_v4i16((LAS s16x4*)p)); }
__device__ __forceinline__ bf16x8 cat8(s16x4 lo, s16x4 hi) { return (bf16x8){lo[0], lo[1], lo[2], lo[3], hi[0], hi[1], hi[2], hi[3]}; }
__device__ __forceinline__ bf16x8 ldsrow(LAS unsigned char* p) { return *(LAS bf16x8*)p; }

namespace pg8 {
constexpr int BM = 256, BK = 64, HALF = 128, HTB = HALF * BK * 2, STAGE_BYTES = 8 * HTB, NXCD = 8, WGM = 8;
__device__ __forceinline__ int lds_byte(int r, int c) { const int st = (r >> 4) * 2 + (c >> 5), rr = r & 15, cc = c & 31, ob = rr * 64 + cc * 2; return st * 1024 + (ob ^ (((ob >> 9) & 1) << 5)); }
__device__ __forceinline__ void stage_rc(int b, int& R, int& C) { const int st = b / 1024, sb = b % 1024, swz = sb ^ (((sb >> 9) & 1) << 5); R = (st >> 1) * 16 + swz / 64; C = (st & 1) * 32 + (swz % 64) / 2; }
__device__ __forceinline__ int perm32(int rho) { const int n = rho >> 4, i = rho & 15; return 8 * (i >> 2) + 4 * n + (i & 3); }

struct Unit { int pm, pn; };
struct Gemm { const bf16_t* A; const bf16_t* Bt; int lda, ldb, M, N, K; };

struct StaticOrder {
    int nM, nN, nwg, G, c;
    __device__ void init(int M, int N, int G_, int c_) { nM = M / BM; nN = N / BM; nwg = nM * nN; G = G_; c = c_; }
    __device__ bool next(int i, Unit& u) const {
        const long L = (long)i * G + c; if (L >= nwg) return false;
        int wgid = (int)L; { const int q = nwg / NXCD, r = nwg % NXCD, xcd = wgid % NXCD, off = wgid / NXCD; wgid = (xcd < r ? xcd * (q + 1) : r * (q + 1) + (xcd - r) * q) + off; }
        const int nig = WGM * nN, gid = wgid / nig, fm = gid * WGM, gsz = (nM - fm) < WGM ? (nM - fm) : WGM;
        u.pm = fm + ((wgid % nig) % gsz); u.pn = (wgid % nig) / gsz; return true;
    }
};

template <class Epi, class Sched>
__device__ __forceinline__ void gemm_phase(LAS unsigned char* lds, const Gemm g, const Sched& S, const Epi& E) {
    const int tid = threadIdx.x, wid = __builtin_amdgcn_readfirstlane(tid >> 6), lane = tid & 63, wr = wid >> 2, wc = wid & 3, fr = lane & 15, fq = lane >> 4;
    const int K = g.K, nt = K / BK;
    unsigned voffA[2], voffB[2];
#pragma unroll
    for (int i = 0; i < 2; ++i) { int R, C; stage_rc(tid * 16 + i * 8192, R, C); const int Rb = (R & ~31) + perm32(R & 31);
        voffA[i] = (unsigned)(R * g.lda + C) * 2u; voffB[i] = (unsigned)(Rb * g.ldb + C) * 2u; }
    const size_t kstep = (size_t)(BK * 2);
    const size_t hstepA = (size_t)HALF * g.lda * 2, hstepB = (size_t)HALF * g.ldb * 2;
    const size_t tstepA = 2 * hstepA, tstepB = 2 * hstepB;
    const unsigned ldsw = (unsigned)wid * 1024u;
    const int aoff = lds_byte(wr * 64 + fr, fq * 8), boff = lds_byte(wc * 32 + fr, fq * 8);
#define PG8_SA(b, h) (((b) * 2 + (h)) * HTB)
#define PG8_SB(b, h) ((4 + (b) * 2 + (h)) * HTB)
#define PG8_STAGE(bufoff, gbase, voff) do { _Pragma("unroll") for (int _i = 0; _i < 2; ++_i) \
        __builtin_amdgcn_global_load_lds((const unsigned*)((const char*)(gbase) + (voff)[_i]), (LAS unsigned*)(lds + (bufoff) + ldsw + _i * 8192), 16, 0, 0); } while (0)
#define PG8_LDA(dst, b, h) do { _Pragma("unroll") for (int m = 0; m < 4; ++m) _Pragma("unroll") for (int k = 0; k < 2; ++k) dst[m][k] = *(const LAS bf16x8*)(lds + PG8_SA(b, h) + aoff + m * 2048 + k * 1024); } while (0)
#define PG8_LDB(dst, b, h) do { _Pragma("unroll") for (int n = 0; n < 2; ++n) _Pragma("unroll") for (int k = 0; k < 2; ++k) dst[n][k] = *(const LAS bf16x8*)(lds + PG8_SB(b, h) + boff + n * 2048 + k * 1024); } while (0)
#define PG8_MMA(ai, bj, At, Bt) do { __builtin_amdgcn_s_setprio(1); _Pragma("unroll") for (int m = 0; m < 4; ++m) _Pragma("unroll") for (int n = 0; n < 2; ++n) _Pragma("unroll") for (int k = 0; k < 2; ++k) \
        acc[ai][bj][m][n] = __builtin_amdgcn_mfma_f32_16x16x32_bf16(Bt[n][k], At[m][k], acc[ai][bj][m][n], 0, 0, 0); __builtin_amdgcn_s_setprio(0); } while (0)
#define PG8_WAIT_V(n) asm volatile("s_waitcnt vmcnt(" #n ")" ::: "memory")
#define PG8_WAIT_L(n) asm volatile("s_waitcnt lgkmcnt(" #n ")" ::: "memory")
#define PG8_BAR __builtin_amdgcn_s_barrier()
#define PG8_SCHED __builtin_amdgcn_sched_barrier(0)
    Unit cur, nxt; int ui = 0;
    if (!S.next(0, cur)) return;
    f32x4 acc[2][2][4][2];
#pragma unroll
    for (int a = 0; a < 2; ++a)
#pragma unroll
        for (int b = 0; b < 2; ++b)
#pragma unroll
            for (int m = 0; m < 4; ++m)
#pragma unroll
                for (int n = 0; n < 2; ++n) acc[a][b][m][n] = (f32x4){0.f, 0.f, 0.f, 0.f};
    bf16x8 At[4][2], B0[2][2], B1[2][2];
    const char* cA = (const char*)g.A + (size_t)cur.pm * tstepA; const char* cB = (const char*)g.Bt + (size_t)cur.pn * tstepB;
    PG8_STAGE(PG8_SB(0, 0), cB, voffB); PG8_STAGE(PG8_SB(0, 1), cB + hstepB, voffB); PG8_STAGE(PG8_SA(0, 0), cA, voffA); PG8_STAGE(PG8_SA(0, 1), cA + hstepA, voffA);
    if (wr == 1) PG8_BAR;
    PG8_WAIT_V(2); PG8_BAR;
    PG8_STAGE(PG8_SB(1, 0), cB + kstep, voffB); PG8_STAGE(PG8_SA(1, 0), cA + kstep, voffA); PG8_STAGE(PG8_SB(1, 1), cB + hstepB + kstep, voffB);
    PG8_WAIT_V(6); PG8_BAR;
    for (;;) {
        const bool has_next = S.next(ui + 1, nxt);
        const char* nA = has_next ? (const char*)g.A + (size_t)nxt.pm * tstepA : cA; const char* nB = has_next ? (const char*)g.Bt + (size_t)nxt.pn * tstepB : cB;
        for (int t = 0; t < nt; t += 2) {
            const bool last = (t == nt - 2);
            const char* a1 = cA + (size_t)(t + 1) * kstep;
            const char* a2 = last ? nA : cA + (size_t)(t + 2) * kstep; const char* b2 = last ? nB : cB + (size_t)(t + 2) * kstep;
            const char* a3 = a2 + kstep; const char* b3 = b2 + kstep;
            PG8_LDB(B0, 0, 0); PG8_LDB(B1, 0, 1); PG8_SCHED; PG8_LDA(At, 0, 0); PG8_STAGE(PG8_SA(1, 1), a1 + hstepA, voffA);
            PG8_WAIT_V(8); PG8_WAIT_L(0); PG8_BAR; PG8_MMA(0, 0, At, B0); PG8_MMA(0, 1, At, B1); PG8_BAR; PG8_SCHED;
            PG8_LDA(At, 0, 1); PG8_STAGE(PG8_SB(0, 0), b2, voffB); PG8_STAGE(PG8_SB(0, 1), b2 + hstepB, voffB); PG8_STAGE(PG8_SA(0, 0), a2, voffA);
            PG8_WAIT_V(8); PG8_WAIT_L(0); PG8_BAR; PG8_MMA(1, 0, At, B0); PG8_MMA(1, 1, At, B1); PG8_BAR; PG8_SCHED;
            PG8_LDB(B0, 1, 0); PG8_LDB(B1, 1, 1); PG8_SCHED; PG8_LDA(At, 1, 0); PG8_STAGE(PG8_SA(0, 1), a2 + hstepA, voffA);
            PG8_WAIT_V(8); PG8_WAIT_L(0); PG8_BAR; PG8_MMA(0, 0, At, B0); PG8_MMA(0, 1, At, B1); PG8_BAR; PG8_SCHED;
            PG8_LDA(At, 1, 1); PG8_STAGE(PG8_SB(1, 0), b3, voffB); PG8_STAGE(PG8_SB(1, 1), b3 + hstepB, voffB); PG8_STAGE(PG8_SA(1, 0), a3, voffA);
            PG8_WAIT_V(8); PG8_WAIT_L(0); PG8_BAR; PG8_MMA(1, 0, At, B0); PG8_MMA(1, 1, At, B1); PG8_BAR; PG8_SCHED;
        }
        if (wr == 0) PG8_BAR;
        E(acc, cur, wr, wc, fr, fq);
        if (!has_next) break;
#pragma unroll
        for (int a = 0; a < 2; ++a)
#pragma unroll
            for (int b = 0; b < 2; ++b)
#pragma unroll
                for (int m = 0; m < 4; ++m)
#pragma unroll
                    for (int n = 0; n < 2; ++n) acc[a][b][m][n] = (f32x4){0.f, 0.f, 0.f, 0.f};
        cur = nxt; cA = nA; cB = nB; ++ui;
        if (wr == 1) PG8_BAR;
    }
    PG8_WAIT_V(0);
    PG8_BAR;
#undef PG8_SA
#undef PG8_SB
#undef PG8_STAGE
#undef PG8_LDA
#undef PG8_LDB
#undef PG8_MMA
#undef PG8_WAIT_V
#undef PG8_WAIT_L
#undef PG8_BAR
#undef PG8_SCHED
}
}
using pg8::Unit;
typedef const f32x4 (&AccRef)[2][2][4][2];

__device__ __forceinline__ void st8bf(bf16_t* p, const float* o) { u32x4 w; w.x = pkbf(o[0], o[1]); w.y = pkbf(o[2], o[3]); w.z = pkbf(o[4], o[5]); w.w = pkbf(o[6], o[7]); *(u32x4*)p = w; }
__device__ __forceinline__ void ld8bf(const bf16_t* p, float* o) { const u32x4 w = *(const u32x4*)p; o[0] = bflo(w.x); o[1] = bfhi(w.x); o[2] = bflo(w.y); o[3] = bfhi(w.y); o[4] = bflo(w.z); o[5] = bfhi(w.z); o[6] = bflo(w.w); o[7] = bfhi(w.w); }

struct EpiIn {
    bf16_t *QA, *KVA, *QR, *KR, *VR, *GR;
    __device__ __forceinline__ void operator()(AccRef acc, const Unit& u, int wr, int wc, int fr, int fq) const {
        const int pn = u.pn; bf16_t* base; int ld, c0, mode = 0;
        if (pn < 4) { base = QA; ld = 1024; c0 = pn * 256; }
        else if (pn == 4) { base = KVA; ld = 256; c0 = 0; }
        else if (pn < 9) { base = QR; ld = 1024; c0 = (pn - 5) * 256; mode = 1; }
        else if (pn < 13) { base = KR; ld = 1024; c0 = (pn - 9) * 256; mode = 2; }
        else if (pn < 21) { base = VR; ld = 2048; c0 = (pn - 13) * 256; }
        else { base = GR; ld = 2048; c0 = (pn - 21) * 256; mode = 3; }
        const int row0 = u.pm * 256 + wr * 64 + fr, cl = c0 + wc * 32 + 8 * fq;
        if (mode == 1 || mode == 2) {
            const float sc = (mode == 2) ? 0.0625f : 1.f;
            float th[2][4];
#pragma unroll
            for (int bj = 0; bj < 2; ++bj)
#pragma unroll
                for (int pp = 0; pp < 4; ++pp) { const int pi = 64 * bj + 16 * wc + 4 * fq + pp; th[bj][pp] = fexp2(-(float)pi * (13.287712379549449f / 127.0f)) * 0.15915494309189535f; }
#pragma unroll
            for (int ai = 0; ai < 2; ++ai)
#pragma unroll
                for (int m = 0; m < 4; ++m) { const int row = row0 + ai * 128 + m * 16; const float pos = (float)(row & (SEQ - 1));
#pragma unroll
                    for (int bj = 0; bj < 2; ++bj) { const f32x4 v0 = acc[ai][bj][m][0], v1 = acc[ai][bj][m][1];
                        const float x[8] = {v0[0], v0[1], v0[2], v0[3], v1[0], v1[1], v1[2], v1[3]}; float o[8];
#pragma unroll
                        for (int pp = 0; pp < 4; ++pp) { const float hi = pos * th[bj][pp], lo = __builtin_fmaf(pos, th[bj][pp], -hi); const float rv = __builtin_amdgcn_fractf(hi) + lo;
                            const float s = __builtin_amdgcn_sinf(rv), c = __builtin_amdgcn_cosf(rv);
                            o[2 * pp] = (x[2 * pp] * c - x[2 * pp + 1] * s) * sc; o[2 * pp + 1] = (x[2 * pp + 1] * c + x[2 * pp] * s) * sc; }
                        st8bf(base + (size_t)row * ld + cl + bj * 128, o); } }
        } else {
#pragma unroll
            for (int ai = 0; ai < 2; ++ai)
#pragma unroll
                for (int m = 0; m < 4; ++m) { const int row = row0 + ai * 128 + m * 16;
#pragma unroll
                    for (int bj = 0; bj < 2; ++bj) { const f32x4 v0 = acc[ai][bj][m][0], v1 = acc[ai][bj][m][1];
                        float o[8] = {v0[0], v0[1], v0[2], v0[3], v1[0], v1[1], v1[2], v1[3]};
                        if (mode == 3) {
#pragma unroll
                            for (int e = 0; e < 8; ++e) o[e] = siluf_(o[e]); }
                        st8bf(base + (size_t)row * ld + cl + bj * 128, o); } }
        }
    }
};
template <int ACT> struct EpiBf {
    bf16_t* O; int ld;
    __device__ __forceinline__ void operator()(AccRef acc, const Unit& u, int wr, int wc, int fr, int fq) const {
        const int row0 = u.pm * 256 + wr * 64 + fr, cl = u.pn * 256 + wc * 32 + 8 * fq;
#pragma unroll
        for (int ai = 0; ai < 2; ++ai)
#pragma unroll
            for (int m = 0; m < 4; ++m) { const int row = row0 + ai * 128 + m * 16;
#pragma unroll
                for (int bj = 0; bj < 2; ++bj) { const f32x4 v0 = acc[ai][bj][m][0], v1 = acc[ai][bj][m][1];
                    float o[8] = {v0[0], v0[1], v0[2], v0[3], v1[0], v1[1], v1[2], v1[3]};
                    if (ACT == 1) {
#pragma unroll
                        for (int e = 0; e < 8; ++e) o[e] = sigmoidf_(o[e]); }
                    st8bf(O + (size_t)row * ld + cl + bj * 128, o); } }
    }
};
struct EpiMerge {
    const bf16_t* SZ; bf16_t* BA;
    __device__ __forceinline__ void operator()(AccRef acc, const Unit& u, int wr, int wc, int fr, int fq) const {
        const int row0 = u.pm * 256 + wr * 64 + fr, cl = u.pn * 256 + wc * 32 + 8 * fq;
#pragma unroll
        for (int ai = 0; ai < 2; ++ai)
#pragma unroll
            for (int m = 0; m < 4; ++m) { const int row = row0 + ai * 128 + m * 16;
#pragma unroll
                for (int bj = 0; bj < 2; ++bj) { const f32x4 v0 = acc[ai][bj][m][0], v1 = acc[ai][bj][m][1];
                    const float x[8] = {v0[0], v0[1], v0[2], v0[3], v1[0], v1[1], v1[2], v1[3]};
                    float sa[8], sr[8], ba[8], o[8]; const int c = cl + bj * 128;
                    ld8bf(SZ + (size_t)row * 2048 + c, sa); ld8bf(SZ + (size_t)row * 2048 + 1024 + c, sr); ld8bf(BA + (size_t)row * 1024 + c, ba);
#pragma unroll
                    for (int e = 0; e < 8; ++e) o[e] = sa[e] * ba[e] + sr[e] * x[e];
                    st8bf(BA + (size_t)row * 1024 + c, o); } }
    }
};
struct EpiOut {
    const float* X; const float* G2; float* X1; bf16_t* XN2; float* SS2;
    __device__ __forceinline__ void operator()(AccRef acc, const Unit& u, int wr, int wc, int fr, int fq) const {
        const int row0 = u.pm * 256 + wr * 64 + fr, cl = u.pn * 256 + wc * 32 + 8 * fq;
        f32x4 gg[2][2];
#pragma unroll
        for (int bj = 0; bj < 2; ++bj) { gg[bj][0] = *(const f32x4*)(G2 + cl + bj * 128); gg[bj][1] = *(const f32x4*)(G2 + cl + bj * 128 + 4); }
#pragma unroll
        for (int ai = 0; ai < 2; ++ai)
#pragma unroll
            for (int m = 0; m < 4; ++m) { const int row = row0 + ai * 128 + m * 16; float ss = 0.f;
#pragma unroll
                for (int bj = 0; bj < 2; ++bj) { const size_t off = (size_t)row * 1024 + cl + bj * 128;
                    const f32x4 a0 = *(const f32x4*)(X + off) + acc[ai][bj][m][0], a1 = *(const f32x4*)(X + off + 4) + acc[ai][bj][m][1];
                    *(f32x4*)(X1 + off) = a0; *(f32x4*)(X1 + off + 4) = a1;
                    ss += (a0[0] * a0[0] + a0[1] * a0[1]) + (a0[2] * a0[2] + a0[3] * a0[3]) + (a1[0] * a1[0] + a1[1] * a1[1]) + (a1[2] * a1[2] + a1[3] * a1[3]);
                    const f32x4 b0 = a0 * gg[bj][0], b1 = a1 * gg[bj][1];
                    const float o[8] = {b0[0], b0[1], b0[2], b0[3], b1[0], b1[1], b1[2], b1[3]};
                    st8bf(XN2 + off, o); }
                ss += __shfl_xor(ss, 16); ss += __shfl_xor(ss, 32);
                if (fq == 0) atomicAdd(SS2 + row, ss); }
    }
};
struct EpiGU {
    const float* SS2; bf16_t* H;
    __device__ __forceinline__ void operator()(AccRef acc, const Unit& u, int wr, int wc, int fr, int fq) const {
        const int row0 = u.pm * 256 + wr * 64 + fr, cl = u.pn * 128 + wc * 32 + 8 * fq;
#pragma unroll
        for (int ai = 0; ai < 2; ++ai)
#pragma unroll
            for (int m = 0; m < 4; ++m) { const int row = row0 + ai * 128 + m * 16;
                const float rstd = 1.0f / sqrtf(SS2[row] * (1.0f / 1024.0f) + EPS);
                const f32x4 g0 = acc[ai][0][m][0] * rstd, g1 = acc[ai][0][m][1] * rstd, u0 = acc[ai][1][m][0] * rstd, u1 = acc[ai][1][m][1] * rstd;
                const float gv[8] = {g0[0], g0[1], g0[2], g0[3], g1[0], g1[1], g1[2], g1[3]}, uv[8] = {u0[0], u0[1], u0[2], u0[3], u1[0], u1[1], u1[2], u1[3]}; float o[8];
#pragma unroll
                for (int e = 0; e < 8; ++e) o[e] = siluf_(gv[e]) * uv[e];
                st8bf(H + (size_t)row * DFF + cl, o); }
    }
};
struct EpiDown {
    const float* X1; float* OUT;
    __device__ __forceinline__ void operator()(AccRef acc, const Unit& u, int wr, int wc, int fr, int fq) const {
        const int row0 = u.pm * 256 + wr * 64 + fr, cl = u.pn * 256 + wc * 32 + 8 * fq;
#pragma unroll
        for (int ai = 0; ai < 2; ++ai)
#pragma unroll
            for (int m = 0; m < 4; ++m) { const int row = row0 + ai * 128 + m * 16;
#pragma unroll
                for (int bj = 0; bj < 2; ++bj) { const size_t off = (size_t)row * 1024 + cl + bj * 128;
                    *(f32x4*)(OUT + off) = *(const f32x4*)(X1 + off) + acc[ai][bj][m][0]; *(f32x4*)(OUT + off + 4) = *(const f32x4*)(X1 + off + 4) + acc[ai][bj][m][1]; } }
    }
};

__device__ __forceinline__ void transpose_item(const float* W, int ldw, bf16_t* WT, int ldt, int k0, int n0, int drow, LAS float* scr, int lane) {
#pragma unroll 8
    for (int i = 0; i < 32; ++i) { const int kk = 2 * i + (lane >> 5); scr[kk * 33 + (lane & 31)] = W[(size_t)(k0 + kk) * ldw + n0 + (lane & 31)]; }
    asm volatile("s_waitcnt lgkmcnt(0)" ::: "memory");
    const int c = lane & 7;
#pragma unroll
    for (int j = 0; j < 4; ++j) { const int n = (lane >> 3) + 8 * j; const LAS float* s = scr + (8 * c) * 33 + n;
        u32x4 o; o.x = pkbf(s[0 * 33], s[1 * 33]); o.y = pkbf(s[2 * 33], s[3 * 33]); o.z = pkbf(s[4 * 33], s[5 * 33]); o.w = pkbf(s[6 * 33], s[7 * 33]);
        *(u32x4*)(WT + (size_t)(drow + n) * ldt + k0 + 8 * c) = o; }
    asm volatile("s_waitcnt lgkmcnt(0)" ::: "memory");
}

__device__ __forceinline__ void attn_unit(LAS unsigned char* lds, bf16_t* QA, const bf16_t* KVA, const float* qg, const float* kg, const float* sinks, int b, int n, int kh, int tid) {
    const int lane = tid & 63, w = __builtin_amdgcn_readfirstlane(tid >> 6), g = lane >> 4, li = lane & 15, q4 = li >> 2, p4 = li & 3;
    LAS unsigned char* Kb = lds; LAS unsigned char* Vb = lds + 256 * 144;
    const long tokband = (long)b * SEQ + 128 * (n - 1);
#pragma unroll
    for (int it = 0; it < 4; ++it) { const int id = tid + 512 * it, s = id >> 3, part = id & 7; const bool valid = (n > 0) || (s >= 128);
        u32x4 kv = {0u, 0u, 0u, 0u}, vv = {0u, 0u, 0u, 0u};
        if (valid) { const bf16_t* src = KVA + (size_t)(tokband + s) * 256 + kh * 64 + part * 8; kv = *(const u32x4*)src; vv = *(const u32x4*)(src + 128); }
        float f[8] = {bflo(kv.x), bfhi(kv.x), bflo(kv.y), bfhi(kv.y), bflo(kv.z), bfhi(kv.z), bflo(kv.w), bfhi(kv.w)};
        float ss = 0.f;
#pragma unroll
        for (int e = 0; e < 8; ++e) ss += f[e] * f[e];
        ss += __shfl_xor(ss, 1); ss += __shfl_xor(ss, 2); ss += __shfl_xor(ss, 4);
        const float rstd = 1.0f / sqrtf(ss * (1.0f / 64.0f) + EPS);
        const f32x4 g0 = *(const f32x4*)(kg + part * 8), g1 = *(const f32x4*)(kg + part * 8 + 4);
        u32x4 ko; ko.x = pkbf(f[0] * rstd * g0[0], f[1] * rstd * g0[1]); ko.y = pkbf(f[2] * rstd * g0[2], f[3] * rstd * g0[3]);
        ko.z = pkbf(f[4] * rstd * g1[0], f[5] * rstd * g1[1]); ko.w = pkbf(f[6] * rstd * g1[2], f[7] * rstd * g1[3]);
        *(LAS u32x4*)(Kb + s * 144 + part * 16) = ko; *(LAS u32x4*)(Vb + s * 144 + part * 16) = vv; }
    __syncthreads();
    const int head = kh * 8 + w; const float sink2 = sinks[head] * LOG2E;
    f32x4 qga[2][2];
#pragma unroll
    for (int kk = 0; kk < 2; ++kk) { qga[kk][0] = *(const f32x4*)(qg + 32 * kk + 8 * g); qga[kk][1] = *(const f32x4*)(qg + 32 * kk + 8 * g + 4); }
    for (int sb = 0; sb < 8; ++sb) {
        const int i = 16 * sb + li; const size_t tok = (size_t)b * SEQ + 128 * n + i;
        bf16_t* qp = QA + tok * 1024 + head * 64 + 8 * g;
        const u32x4 q0 = *(const u32x4*)qp, q1 = *(const u32x4*)(qp + 32);
        float f0[8] = {bflo(q0.x), bfhi(q0.x), bflo(q0.y), bfhi(q0.y), bflo(q0.z), bfhi(q0.z), bflo(q0.w), bfhi(q0.w)};
        float f1[8] = {bflo(q1.x), bfhi(q1.x), bflo(q1.y), bfhi(q1.y), bflo(q1.z), bfhi(q1.z), bflo(q1.w), bfhi(q1.w)};
        float ss = 0.f;
#pragma unroll
        for (int e = 0; e < 8; ++e) ss += f0[e] * f0[e] + f1[e] * f1[e];
        ss += __shfl_xor(ss, 16); ss += __shfl_xor(ss, 32);
        const float qs = (1.0f / sqrtf(ss * (1.0f / 64.0f) + EPS)) * (0.125f * LOG2E);
        bf16x8 Qf[2];
        { u32x4 t; t.x = pkbf(f0[0] * qs * qga[0][0][0], f0[1] * qs * qga[0][0][1]); t.y = pkbf(f0[2] * qs * qga[0][0][2], f0[3] * qs * qga[0][0][3]);
          t.z = pkbf(f0[4] * qs * qga[0][1][0], f0[5] * qs * qga[0][1][1]); t.w = pkbf(f0[6] * qs * qga[0][1][2], f0[7] * qs * qga[0][1][3]); Qf[0] = __builtin_bit_cast(bf16x8, t); }
        { u32x4 t; t.x = pkbf(f1[0] * qs * qga[1][0][0], f1[1] * qs * qga[1][0][1]); t.y = pkbf(f1[2] * qs * qga[1][0][2], f1[3] * qs * qga[1][0][3]);
          t.z = pkbf(f1[4] * qs * qga[1][1][0], f1[5] * qs * qga[1][1][1]); t.w = pkbf(f1[6] * qs * qga[1][1][2], f1[7] * qs * qga[1][1][3]); Qf[1] = __builtin_bit_cast(bf16x8, t); }
        const int t0 = sb < 6 ? sb : 6;
        f32x4 sc[10];
#pragma unroll
        for (int tt = 0; tt < 10; ++tt) { LAS unsigned char* kp = Kb + (16 * (t0 + tt) + li) * 144 + 16 * g;
            f32x4 a = (f32x4){0.f, 0.f, 0.f, 0.f}; a = mfma16(ldsrow(kp), Qf[0], a); a = mfma16(ldsrow(kp + 64), Qf[1], a); sc[tt] = a; }
        float mx = sink2;
#pragma unroll
        for (int tt = 0; tt < 10; ++tt)
#pragma unroll
            for (int jj = 0; jj < 4; ++jj) { const int s = 16 * (t0 + tt) + 4 * g + jj; const bool ok = (s > i) && (s <= i + 128) && ((n > 0) || (s >= 128));
                const float v = ok ? sc[tt][jj] : -INFINITY; sc[tt][jj] = v; mx = fmaxf(mx, v); }
        mx = fmaxf(mx, __shfl_xor(mx, 16)); mx = fmaxf(mx, __shfl_xor(mx, 32));
        float l = 0.f;
#pragma unroll
        for (int tt = 0; tt < 10; ++tt)
#pragma unroll
            for (int jj = 0; jj < 4; ++jj) { const float p = fexp2(sc[tt][jj] - mx); sc[tt][jj] = p; l += p; }
        l += __shfl_xor(l, 16); l += __shfl_xor(l, 32); l += fexp2(sink2 - mx);
        const float inv = 1.0f / l;
        bf16x8 Pb[5];
#pragma unroll
        for (int k2 = 0; k2 < 5; ++k2) { u32x4 t; t.x = pkbf(sc[2 * k2][0], sc[2 * k2][1]); t.y = pkbf(sc[2 * k2][2], sc[2 * k2][3]); t.z = pkbf(sc[2 * k2 + 1][0], sc[2 * k2 + 1][1]); t.w = pkbf(sc[2 * k2 + 1][2], sc[2 * k2 + 1][3]); Pb[k2] = __builtin_bit_cast(bf16x8, t); }
#pragma unroll
        for (int dt = 0; dt < 4; ++dt) { f32x4 o = (f32x4){0.f, 0.f, 0.f, 0.f};
#pragma unroll
            for (int k2 = 0; k2 < 5; ++k2) { LAS unsigned char* vp = Vb + (16 * (t0 + 2 * k2) + 4 * g + q4) * 144 + (16 * dt + 4 * p4) * 2;
                o = mfma16(cat8(ldstr(vp), ldstr(vp + 16 * 144)), Pb[k2], o); }
            u32x2 wv; wv.x = pkbf(o[0] * inv, o[1] * inv); wv.y = pkbf(o[2] * inv, o[3] * inv);
            *(u32x2*)(QA + tok * 1024 + head * 64 + 16 * dt + 4 * g) = wv; }
    }
    __syncthreads();
}

constexpr int RK_STRIDE = 528, RV_STRIDE = 144, R_KOFF = 0, R_VOFF = 128 * RK_STRIDE, R_SOFF = R_VOFF + 128 * RV_STRIDE;
__device__ __forceinline__ void ret_unit(LAS unsigned char* lds, const bf16_t* QR, const bf16_t* KR, bf16_t* VR, float* SS, int b, int h, int vs, int tid) {
    const int lane = tid & 63, w = __builtin_amdgcn_readfirstlane(tid >> 6), g = lane >> 4, li = lane & 15, q4 = li >> 2, p4 = li & 3;
    LAS unsigned char* Kl = lds + R_KOFF; LAS unsigned char* Vl = lds + R_VOFF; LAS unsigned char* Sl = lds + R_SOFF;
    const float lg = log2f(1.0f - exp2f(-5.0f - (float)h));
    const int irow = 16 * w + li;
    const float rho = fexp2((float)(irow - 127) * lg), xi = fexp2((float)(irow + 1) * lg), g128 = fexp2(128.0f * lg);
    const float zeta0 = fexp2((float)(127 - (tid >> 3)) * lg), zeta1 = fexp2((float)(127 - 64 - (tid >> 3)) * lg);
    for (int id = tid; id < 64 * RK_STRIDE / 16; id += 512) *(LAS u32x4*)(Sl + id * 16) = (u32x4){0u, 0u, 0u, 0u};
    f32x4 S[2][4];
#pragma unroll
    for (int a = 0; a < 2; ++a)
#pragma unroll
        for (int v = 0; v < 4; ++v) S[a][v] = (f32x4){0.f, 0.f, 0.f, 0.f};
    for (int c = 0; c < 64; ++c) {
        const size_t tok0 = (size_t)b * SEQ + 128 * c;
        u32x4 kreg[8], vreg[2]; bf16x8 Qf[8];
#pragma unroll
        for (int it = 0; it < 8; ++it) { const int id = tid + 512 * it, row = id >> 5, part = id & 31; kreg[it] = *(const u32x4*)(KR + (tok0 + row) * 1024 + h * 256 + part * 8); }
#pragma unroll
        for (int it = 0; it < 2; ++it) { const int id = tid + 512 * it, row = id >> 3, part = id & 7; vreg[it] = *(const u32x4*)(VR + (tok0 + row) * 2048 + h * 512 + vs * 64 + part * 8); }
#pragma unroll
        for (int kk = 0; kk < 8; ++kk) Qf[kk] = *(const bf16x8*)(QR + (tok0 + irow) * 1024 + h * 256 + 32 * kk + 8 * g);
        __syncthreads();
#pragma unroll
        for (int it = 0; it < 8; ++it) { const int id = tid + 512 * it, row = id >> 5, part = id & 31; *(LAS u32x4*)(Kl + row * RK_STRIDE + part * 16) = kreg[it]; }
#pragma unroll
        for (int it = 0; it < 2; ++it) { const int id = tid + 512 * it, row = id >> 3, part = id & 7; const float z = it ? zeta1 : zeta0; const u32x4 v = vreg[it];
            u32x4 o; o.x = pkbf(bflo(v.x) * z, bfhi(v.x) * z); o.y = pkbf(bflo(v.y) * z, bfhi(v.y) * z); o.z = pkbf(bflo(v.z) * z, bfhi(v.z) * z); o.w = pkbf(bflo(v.w) * z, bfhi(v.w) * z);
            *(LAS u32x4*)(Vl + row * RV_STRIDE + part * 16) = o; }
        __syncthreads();
        f32x4 P[8];
#pragma unroll
        for (int t = 0; t < 8; ++t) { P[t] = (f32x4){0.f, 0.f, 0.f, 0.f};
            if (t <= w) { LAS unsigned char* kp = Kl + (16 * t + li) * RK_STRIDE + 16 * g;
#pragma unroll
                for (int kk = 0; kk < 8; ++kk) P[t] = mfma16(ldsrow(kp + 64 * kk), Qf[kk], P[t]);
                if (t == w) {
#pragma unroll
                    for (int jj = 0; jj < 4; ++jj) if (4 * g + jj > li) P[t][jj] = 0.f; } } }
        bf16x8 Pb[4];
#pragma unroll
        for (int k2 = 0; k2 < 4; ++k2) { u32x4 t; t.x = pkbf(P[2 * k2][0], P[2 * k2][1]); t.y = pkbf(P[2 * k2][2], P[2 * k2][3]); t.z = pkbf(P[2 * k2 + 1][0], P[2 * k2 + 1][1]); t.w = pkbf(P[2 * k2 + 1][2], P[2 * k2 + 1][3]); Pb[k2] = __builtin_bit_cast(bf16x8, t); }
        float ssq = 0.f;
#pragma unroll
        for (int vt = 0; vt < 4; ++vt) { f32x4 a1 = (f32x4){0.f, 0.f, 0.f, 0.f}, a2 = (f32x4){0.f, 0.f, 0.f, 0.f};
#pragma unroll
            for (int k2 = 0; k2 < 4; ++k2) if (2 * k2 <= w) { LAS unsigned char* vp = Vl + (32 * k2 + 4 * g + q4) * RV_STRIDE + (16 * vt + 4 * p4) * 2;
                a1 = mfma16(cat8(ldstr(vp), ldstr(vp + 16 * RV_STRIDE)), Pb[k2], a1); }
            LAS unsigned char* sp = Sl + (16 * vt + li) * RK_STRIDE + 16 * g;
#pragma unroll
            for (int kk = 0; kk < 8; ++kk) a2 = mfma16(ldsrow(sp + 64 * kk), Qf[kk], a2);
            const f32x4 o = a1 * rho + a2 * xi;
            ssq += (o[0] * o[0] + o[1] * o[1]) + (o[2] * o[2] + o[3] * o[3]);
            u32x2 wv; wv.x = pkbf(o[0], o[1]); wv.y = pkbf(o[2], o[3]);
            *(u32x2*)(VR + (tok0 + irow) * 2048 + h * 512 + vs * 64 + 16 * vt + 4 * g) = wv; }
        ssq += __shfl_xor(ssq, 16); ssq += __shfl_xor(ssq, 32);
        if (g == 0) atomicAdd(SS + (tok0 + irow) * 4 + h, ssq);
        __syncthreads();
#pragma unroll
        for (int a = 0; a < 2; ++a)
#pragma unroll
            for (int v = 0; v < 4; ++v) S[a][v] = S[a][v] * g128;
#pragma unroll
        for (int kk = 0; kk < 4; ++kk) { bf16x8 Af[2], Bf[4];
#pragma unroll
            for (int a = 0; a < 2; ++a) { LAS unsigned char* kp = Kl + (32 * kk + 8 * g + q4) * RK_STRIDE + (16 * (2 * w + a) + 4 * p4) * 2; Af[a] = cat8(ldstr(kp), ldstr(kp + 4 * RK_STRIDE)); }
#pragma unroll
            for (int v = 0; v < 4; ++v) { LAS unsigned char* vp = Vl + (32 * kk + 8 * g + q4) * RV_STRIDE + (16 * v + 4 * p4) * 2; Bf[v] = cat8(ldstr(vp), ldstr(vp + 4 * RV_STRIDE)); }
#pragma unroll
            for (int a = 0; a < 2; ++a)
#pragma unroll
                for (int v = 0; v < 4; ++v) S[a][v] = mfma16(Af[a], Bf[v], S[a][v]); }
#pragma unroll
        for (int a = 0; a < 2; ++a)
#pragma unroll
            for (int v = 0; v < 4; ++v) { u32x2 wv; wv.x = pkbf(S[a][v][0], S[a][v][1]); wv.y = pkbf(S[a][v][2], S[a][v][3]);
                *(LAS u32x2*)(Sl + (16 * v + li) * RK_STRIDE + (16 * (2 * w + a) + 4 * g) * 2) = wv; }
    }
    __syncthreads();
}

struct Args { const float* in[13]; float* out; unsigned char* ws; int ph_lo, ph_hi, coop, pad; };

__global__ void __launch_bounds__(512, 2) fwd_kernel(Args a) {
    extern __shared__ __attribute__((aligned(16))) unsigned char lds_raw[];
    LAS unsigned char* lds = (LAS unsigned char*)lds_raw;
    cg::grid_group grid = cg::this_grid();
    const int tid = threadIdx.x, lane = tid & 63, wave = __builtin_amdgcn_readfirstlane(tid >> 6);
    const int G = gridDim.x, bid = blockIdx.x;
    const int gw = bid * 8 + wave, NGW = G * 8;
    unsigned char* ws = a.ws;
    const float* x = a.in[0];
    bf16_t* QA = (bf16_t*)(ws + WS_QA); bf16_t* KVA = (bf16_t*)(ws + WS_KVA); bf16_t* QR = (bf16_t*)(ws + WS_QR); bf16_t* KR = (bf16_t*)(ws + WS_KR);
    bf16_t* VR = (bf16_t*)(ws + WS_VR); bf16_t* GR = (bf16_t*)(ws + WS_GR);
    bf16_t* WIN = (bf16_t*)(ws + WS_WIN); bf16_t* WBA = (bf16_t*)(ws + WS_WBA); bf16_t* WBR = (bf16_t*)(ws + WS_WBR); bf16_t* WOUT = (bf16_t*)(ws + WS_WOUT);
    bf16_t* WGU = (bf16_t*)(ws + WS_WGU); bf16_t* WD = (bf16_t*)(ws + WS_WD);
    float* SS = (float*)(ws + WS_SS); float* SS2 = (float*)(ws + WS_SS2);
    bf16_t* SZ = (bf16_t*)(ws + WS_SZ); float* X1 = (float*)(ws + WS_X1); bf16_t* XN2 = (bf16_t*)(ws + WS_XN2); bf16_t* H = (bf16_t*)(ws + WS_H);
    bf16_t* XN = (bf16_t*)((unsigned char*)a.out + OUT_XN); bf16_t* BA = (bf16_t*)((unsigned char*)a.out + OUT_BA);
    const int lo = a.ph_lo, hi = a.ph_hi;
#define IN(k) (lo <= (k) && (k) < hi)
#define SEAM(k) do { if (a.coop && IN(k) && IN((k) + 1)) grid.sync(); } while (0)

    if (IN(0)) {
        LAS float* scr = (LAS float*)(lds + wave * 16384);
        constexpr int I_IN = 16 * (DIN / 32), I_BA = 16 * 32, I_BR = 32 * 32, I_OUT = 16 * 32, I_G = 16 * (DFF / 32), I_D = (DFF / 64) * 32;
        constexpr int NITEMS = I_IN + I_BA + I_BR + I_OUT + 2 * I_G + I_D;
        for (int it = gw; it < NITEMS; it += NGW) {
            int r = it;
            if (r < I_IN) { const int nb = DIN / 32, kb = r / nb, n0 = 32 * (r % nb); transpose_item(a.in[2], DIN, WIN, 1024, 64 * kb, n0, n0, scr, lane); continue; } r -= I_IN;
            if (r < I_BA) { const int kb = r / 32, n0 = 32 * (r % 32); transpose_item(a.in[6], 1024, WBA, 1024, 64 * kb, n0, n0, scr, lane); continue; } r -= I_BA;
            if (r < I_BR) { const int kb = r / 32, n0 = 32 * (r % 32); transpose_item(a.in[7], 1024, WBR, 2048, 64 * kb, n0, n0, scr, lane); continue; } r -= I_BR;
            if (r < I_OUT) { const int kb = r / 32, n0 = 32 * (r % 32); transpose_item(a.in[8], 1024, WOUT, 1024, 64 * kb, n0, n0, scr, lane); continue; } r -= I_OUT;
            if (r < I_G) { const int nb = DFF / 32, kb = r / nb, n0 = 32 * (r % nb); transpose_item(a.in[10], DFF, WGU, 1024, 64 * kb, n0, 256 * (n0 >> 7) + (n0 & 127), scr, lane); continue; } r -= I_G;
            if (r < I_G) { const int nb = DFF / 32, kb = r / nb, n0 = 32 * (r % nb); transpose_item(a.in[11], DFF, WGU, 1024, 64 * kb, n0, 256 * (n0 >> 7) + 128 + (n0 & 127), scr, lane); continue; } r -= I_G;
            { const int kb = r / 32, n0 = 32 * (r % 32); transpose_item(a.in[12], 1024, WD, DFF, 64 * kb, n0, n0, scr, lane); }
        }
        const float* g1 = a.in[1];
        f32x4 gv[4];
#pragma unroll
        for (int j = 0; j < 4; ++j) gv[j] = *(const f32x4*)(g1 + 4 * lane + 256 * j);
        for (int m = gw; m < M_TOK; m += NGW) {
            const f32x4* xr = (const f32x4*)(x + (size_t)m * DM) + lane; f32x4 v[4]; float s = 0.f;
#pragma unroll
            for (int j = 0; j < 4; ++j) { v[j] = xr[64 * j]; s += (v[j][0] * v[j][0] + v[j][1] * v[j][1]) + (v[j][2] * v[j][2] + v[j][3] * v[j][3]); }
            const float rstd = 1.0f / sqrtf(wave_sum(s) * (1.0f / DM) + EPS);
            u32x2* o8 = (u32x2*)(XN + (size_t)m * DM) + lane;
#pragma unroll
            for (int j = 0; j < 4; ++j) { const f32x4 t = v[j] * rstd * gv[j]; u32x2 wv; wv.x = pkbf(t[0], t[1]); wv.y = pkbf(t[2], t[3]); o8[64 * j] = wv; }
        }
        for (int i = bid * 512 + tid; i < M_TOK * 4 / 4; i += G * 512) ((f32x4*)SS)[i] = (f32x4){0.f, 0.f, 0.f, 0.f};
        for (int i = bid * 512 + tid; i < M_TOK / 4; i += G * 512) ((f32x4*)SS2)[i] = (f32x4){0.f, 0.f, 0.f, 0.f};
        __syncthreads();
    }
    SEAM(0);
    if (IN(1)) {
        pg8::Gemm g{XN, WIN, 1024, 1024, M_TOK, N_IN1, 1024}; pg8::StaticOrder S; S.init(M_TOK, N_IN1, G, bid);
        EpiIn E{QA, KVA, QR, KR, VR, GR};
        pg8::gemm_phase(lds, g, S, E);
    }
    SEAM(1);
    if (IN(2)) {
        for (int u = bid; u < 256; u += G) { const int xcd = u & 7, idx = u >> 3, bh = xcd * 4 + (idx >> 3), vs = idx & 7; ret_unit(lds, QR, KR, VR, SS, bh >> 2, bh & 3, vs, tid); }
        for (int u = bid; u < 1024; u += G) attn_unit(lds, QA, KVA, a.in[3], a.in[4], a.in[5], u >> 7, (u >> 1) & 63, u & 1, tid);
    }
    SEAM(2);
    if (IN(3)) {
        for (size_t id = (size_t)bid * 512 + tid; id < (size_t)M_TOK * 256; id += (size_t)G * 512) { const size_t row = id >> 8; const int c8 = (int)(id & 255), h = c8 >> 6;
            const float rstd = 1.0f / sqrtf(SS[row * 4 + h] * (1.0f / 512.0f) + EPS);
            float r[8], gs[8], o[8]; ld8bf(VR + id * 8, r); ld8bf(GR + id * 8, gs);
#pragma unroll
            for (int e = 0; e < 8; ++e) o[e] = r[e] * gs[e] * rstd;
            st8bf(VR + id * 8, o); }
        { pg8::Gemm g{XN, WIN + (size_t)N_IN1 * 1024, 1024, 1024, M_TOK, 2048, 1024}; pg8::StaticOrder S; S.init(M_TOK, 2048, G, bid); EpiBf<1> E{SZ, 2048}; pg8::gemm_phase(lds, g, S, E); }
        { pg8::Gemm g{QA, WBA, 1024, 1024, M_TOK, 1024, 1024}; pg8::StaticOrder S; S.init(M_TOK, 1024, G, bid); EpiBf<0> E{BA, 1024}; pg8::gemm_phase(lds, g, S, E); }
    }
    SEAM(3);
    if (IN(4)) {
        pg8::Gemm g{VR, WBR, 2048, 2048, M_TOK, 1024, 2048}; pg8::StaticOrder S; S.init(M_TOK, 1024, G, bid); EpiMerge E{SZ, BA}; pg8::gemm_phase(lds, g, S, E);
    }
    SEAM(4);
    if (IN(5)) {
        pg8::Gemm g{BA, WOUT, 1024, 1024, M_TOK, 1024, 1024}; pg8::StaticOrder S; S.init(M_TOK, 1024, G, bid); EpiOut E{x, a.in[9], X1, XN2, SS2}; pg8::gemm_phase(lds, g, S, E);
    }
    SEAM(5);
    if (IN(6)) {
        pg8::Gemm g{XN2, WGU, 1024, 1024, M_TOK, 2 * DFF, 1024}; pg8::StaticOrder S; S.init(M_TOK, 2 * DFF, G, bid); EpiGU E{SS2, H}; pg8::gemm_phase(lds, g, S, E);
    }
    SEAM(6);
    if (IN(7)) {
        pg8::Gemm g{H, WD, DFF, DFF, M_TOK, 1024, DFF}; pg8::StaticOrder S; S.init(M_TOK, 1024, G, bid); EpiDown E{X1, a.out}; pg8::gemm_phase(lds, g, S, E);
    }
#undef IN
#undef SEAM
}

#ifndef MK_COOP
#define MK_COOP 1
#endif
extern "C" void kernel_launch(void* const* d_in, const int* in_sizes, int n_in, void* d_out, int out_size, void* d_ws, size_t ws_size, hipStream_t stream) {
    static int grid = 0;
    if (grid == 0) {
        if (n_in != 13 || in_sizes[0] != M_TOK * DM || out_size != M_TOK * DM || ws_size < WS_END) { fprintf(stderr, "kernel_launch: unexpected shapes (n_in %d, in0 %d, out %d, ws %zu)\n", n_in, n_in > 0 ? in_sizes[0] : -1, out_size, ws_size); grid = -1; return; }
        int dev = 0, cus = 0, per_cu = 0;
        hipGetDevice(&dev); hipDeviceGetAttribute(&cus, hipDeviceAttributeMultiprocessorCount, dev);
        if (hipFuncSetAttribute((const void*)fwd_kernel, hipFuncAttributeMaxDynamicSharedMemorySize, LDS_BYTES) != hipSuccess) { fprintf(stderr, "kernel_launch: hipFuncSetAttribute failed\n"); grid = -1; return; }
        if (hipOccupancyMaxActiveBlocksPerMultiprocessor(&per_cu, (const void*)fwd_kernel, 512, LDS_BYTES) != hipSuccess || per_cu < 1) { fprintf(stderr, "kernel_launch: occupancy query says %d\n", per_cu); per_cu = 1; }
        (void)hipGetLastError();
        grid = cus * per_cu; if (grid > 256) grid = 256;
        fprintf(stderr, "kernel_launch: grid %d (cus %d, per_cu %d)\n", grid, cus, per_cu);
    }
    if (grid < 0) return;
    Args a{};
    for (int i = 0; i < 13; ++i) a.in[i] = (const float*)d_in[i];
    a.out = (float*)d_out; a.ws = (unsigned char*)d_ws;
#if MK_COOP
    a.ph_lo = 0; a.ph_hi = 8; a.coop = 1; a.pad = 0;
    void* args[] = {&a};
    hipError_t e = hipLaunchCooperativeKernel((const void*)fwd_kernel, dim3(grid), dim3(512), args, LDS_BYTES, stream);
    if (e != hipSuccess) fprintf(stderr, "cooperative launch failed: %s (grid %d)\n", hipGetErrorString(e), grid);
#else
    for (int p = 0; p < 8; ++p) { a.ph_lo = p; a.ph_hi = p + 1; a.coop = 0; a.pad = 0; hipLaunchKernelGGL(fwd_kernel, dim3(grid), dim3(512), LDS_BYTES, stream, a); }
#endif
}
```

```cpp
#include <hip/hip_runtime.h>
#include <hip/hip_cooperative_groups.h>
#include <cstdio>
#include <cstdint>
namespace cg = cooperative_groups;

#define LAS __attribute__((address_space(3)))
typedef unsigned short bf16_t;
typedef short bf16x8 __attribute__((ext_vector_type(8)));
typedef short s16x4 __attribute__((ext_vector_type(4)));
typedef float f32x4 __attribute__((ext_vector_type(4)));
typedef float f32x2 __attribute__((ext_vector_type(2)));
typedef unsigned u32x4 __attribute__((ext_vector_type(4)));
typedef unsigned u32x2 __attribute__((ext_vector_type(2)));
typedef __bf16 bf16x2_t __attribute__((ext_vector_type(2)));

constexpr int M_TOK = 65536, SEQ = 8192, DM = 1024, DIN = 9472, DFF = 2816;
constexpr int N_IN1 = 7424;
constexpr float EPS = 1e-6f;
constexpr float LOG2E = 1.4426950408889634f;

constexpr size_t MiB = 1u << 20;
constexpr size_t WS_QA = 0, WS_KVA = 128 * MiB, WS_QR = 160 * MiB, WS_KR = 288 * MiB, WS_VR = 416 * MiB, WS_GR = 672 * MiB;
constexpr size_t WS_WIN = 928 * MiB, WS_WBA = 947 * MiB, WS_WBR = 949 * MiB, WS_WOUT = 953 * MiB, WS_WGU = 955 * MiB, WS_WD = 966 * MiB;
constexpr size_t WS_SS = 972 * MiB, WS_SS2 = 973 * MiB, WS_END = 974 * MiB;
constexpr size_t WS_SZ = WS_QR, WS_X1 = WS_GR, WS_XN2 = WS_QA, WS_H = WS_QR;
constexpr size_t OUT_XN = 0, OUT_BA = 128 * MiB;

constexpr int LDS_BYTES = 135168;

__device__ __forceinline__ unsigned pkbf(float lo, float hi) { f32x2 v = {lo, hi}; bf16x2_t b = __builtin_convertvector(v, bf16x2_t); return __builtin_bit_cast(unsigned, b); }
__device__ __forceinline__ float bflo(unsigned u) { return __uint_as_float(u << 16); }
__device__ __forceinline__ float bfhi(unsigned u) { return __uint_as_float(u & 0xffff0000u); }
__device__ __forceinline__ float fexp2(float x) { return __builtin_amdgcn_exp2f(x); }
__device__ __forceinline__ float frcp(float x) { return __builtin_amdgcn_rcpf(x); }
__device__ __forceinline__ float sigmoidf_(float x) { return frcp(1.f + fexp2(-x * LOG2E)); }
__device__ __forceinline__ float siluf_(float x) { return x * sigmoidf_(x); }
__device__ __forceinline__ float wave_sum(float v) {
#pragma unroll
    for (int o = 1; o < 64; o <<= 1) v += __shfl_xor(v, o);
    return v;
}
__device__ __forceinline__ f32x4 mfma16(bf16x8 a, bf16x8 b, f32x4 c) { return __builtin_amdgcn_mfma_f32_16x16x32_bf16(a, b, c, 0, 0, 0); }
__device__ __forceinline__ s16x4 ldstr(LAS unsigned char* p) { return __builtin_bit_cast(s16x4, __builtin_amdgcn_ds_read_tr16_b64_v4i16((LAS s16x4*)p)); }
__device__ __forceinline__ bf16x8 cat8(s16x4 lo, s16x4 hi) { return (bf16x8){lo[0], lo[1], lo[2], lo[3], hi[0], hi[1], hi[2], hi[3]}; }
__device__ __forceinline__ bf16x8 ldsrow(LAS unsigned char* p) { return *(LAS bf16x8*)p; }

namespace pg8 {
constexpr int BM = 256, BK = 64, HALF = 128, HTB = HALF * BK * 2, STAGE_BYTES = 8 * HTB, NXCD = 8, WGM = 8;
__device__ __forceinline__ int lds_byte(int r, int c) { const int st = (r >> 4) * 2 + (c >> 5), rr = r & 15, cc = c & 31, ob = rr * 64 + cc * 2; return st * 1024 + (ob ^ (((ob >> 9) & 1) << 5)); }
__device__ __forceinline__ void stage_rc(int b, int& R, int& C) { const int st = b / 1024, sb = b % 1024, swz = sb ^ (((sb >> 9) & 1) << 5); R = (st >> 1) * 16 + swz / 64; C = (st & 1) * 32 + (swz % 64) / 2; }
__device__ __forceinline__ int perm32(int rho) { const int n = rho >> 4, i = rho & 15; return 8 * (i >> 2) + 4 * n + (i & 3); }

struct Unit { int pm, pn; };
struct Gemm { const bf16_t* A; const bf16_t* Bt; int lda, ldb, M, N, K; };

struct StaticOrder {
    int nM, nN, nwg, G, c;
    __device__ void init(int M, int N, int G_, int c_) { nM = M / BM; nN = N / BM; nwg = nM * nN; G = G_; c = c_; }
    __device__ bool next(int i, Unit& u) const {
        const long L = (long)i * G + c; if (L >= nwg) return false;
        int wgid = (int)L; { const int q = nwg / NXCD, r = nwg % NXCD, xcd = wgid % NXCD, off = wgid / NXCD; wgid = (xcd < r ? xcd * (q + 1) : r * (q + 1) + (xcd - r) * q) + off; }
        const int nig = WGM * nN, gid = wgid / nig, fm = gid * WGM, gsz = (nM - fm) < WGM ? (nM - fm) : WGM;
        u.pm = fm + ((wgid % nig) % gsz); u.pn = (wgid % nig) / gsz; return true;
    }
};

template <class Epi, class Sched>
__device__ __forceinline__ void gemm_phase(LAS unsigned char* lds, const Gemm g, const Sched& S, const Epi& E) {
    const int tid = threadIdx.x, wid = __builtin_amdgcn_readfirstlane(tid >> 6), lane = tid & 63, wr = wid >> 2, wc = wid & 3, fr = lane & 15, fq = lane >> 4;
    const int K = g.K, nt = K / BK;
    unsigned voffA[2], voffB[2];
#pragma unroll
    for (int i = 0; i < 2; ++i) { int R, C; stage_rc(tid * 16 + i * 8192, R, C); const int Rb = (R & ~31) + perm32(R & 31);
        voffA[i] = (unsigned)(R * g.lda + C) * 2u; voffB[i] = (unsigned)(Rb * g.ldb + C) * 2u; }
    const size_t kstep = (size_t)(BK * 2);
    const size_t hstepA = (size_t)HALF * g.lda * 2, hstepB = (size_t)HALF * g.ldb * 2;
    const size_t tstepA = 2 * hstepA, tstepB = 2 * hstepB;
    const unsigned ldsw = (unsigned)wid * 1024u;
    const int aoff = lds_byte(wr * 64 + fr, fq * 8), boff = lds_byte(wc * 32 + fr, fq * 8);
#define PG8_SA(b, h) (((b) * 2 + (h)) * HTB)
#define PG8_SB(b, h) ((4 + (b) * 2 + (h)) * HTB)
#define PG8_STAGE(bufoff, gbase, voff) do { _Pragma("unroll") for (int _i = 0; _i < 2; ++_i) \
        __builtin_amdgcn_global_load_lds((const unsigned*)((const char*)(gbase) + (voff)[_i]), (LAS unsigned*)(lds + (bufoff) + ldsw + _i * 8192), 16, 0, 0); } while (0)
#define PG8_LDA(dst, b, h) do { _Pragma("unroll") for (int m = 0; m < 4; ++m) _Pragma("unroll") for (int k = 0; k < 2; ++k) dst[m][k] = *(const LAS bf16x8*)(lds + PG8_SA(b, h) + aoff + m * 2048 + k * 1024); } while (0)
#define PG8_LDB(dst, b, h) do { _Pragma("unroll") for (int n = 0; n < 2; ++n) _Pragma("unroll") for (int k = 0; k < 2; ++k) dst[n][k] = *(const LAS bf16x8*)(lds + PG8_SB(b, h) + boff + n * 2048 + k * 1024); } while (0)
#define PG8_MMA(ai, bj, At, Bt) do { __builtin_amdgcn_s_setprio(1); _Pragma("unroll") for (int m = 0; m < 4; ++m) _Pragma("unroll") for (int n = 0; n < 2; ++n) _Pragma("unroll") for (int k = 0; k < 2; ++k) \
        acc[ai][bj][m][n] = __builtin_amdgcn_mfma_f32_16x16x32_bf16(Bt[n][k], At[m][k], acc[ai][bj][m][n], 0, 0, 0); __builtin_amdgcn_s_setprio(0); } while (0)
#define PG8_WAIT_V(n) asm volatile("s_waitcnt vmcnt(" #n ")" ::: "memory")
#define PG8_WAIT_L(n) asm volatile("s_waitcnt lgkmcnt(" #n ")" ::: "memory")
#define PG8_BAR __builtin_amdgcn_s_barrier()
#define PG8_SCHED __builtin_amdgcn_sched_barrier(0)
    Unit cur, nxt; int ui = 0;
    if (!S.next(0, cur)) return;
    f32x4 acc[2][2][4][2];
#pragma unroll
    for (int a = 0; a < 2; ++a)
#pragma unroll
        for (int b = 0; b < 2; ++b)
#pragma unroll
            for (int m = 0; m < 4; ++m)
#pragma unroll
                for (int n = 0; n < 2; ++n) acc[a][b][m][n] = (f32x4){0.f, 0.f, 0.f, 0.f};
    bf16x8 At[4][2], B0[2][2], B1[2][2];
    const char* cA = (const char*)g.A + (size_t)cur.pm * tstepA; const char* cB = (const char*)g.Bt + (size_t)cur.pn * tstepB;
    PG8_STAGE(PG8_SB(0, 0), cB, voffB); PG8_STAGE(PG8_SB(0, 1), cB + hstepB, voffB); PG8_STAGE(PG8_SA(0, 0), cA, voffA); PG8_STAGE(PG8_SA(0, 1), cA + hstepA, voffA);
    if (wr == 1) PG8_BAR;
    PG8_WAIT_V(2); PG8_BAR;
    PG8_STAGE(PG8_SB(1, 0), cB + kstep, voffB); PG8_STAGE(PG8_SA(1, 0), cA + kstep, voffA); PG8_STAGE(PG8_SB(1, 1), cB + hstepB + kstep, voffB);
    PG8_WAIT_V(6); PG8_BAR;
    for (;;) {
        const bool has_next = S.next(ui + 1, nxt);
        const char* nA = has_next ? (const char*)g.A + (size_t)nxt.pm * tstepA : cA; const char* nB = has_next ? (const char*)g.Bt + (size_t)nxt.pn * tstepB : cB;
        for (int t = 0; t < nt; t += 2) {
            const bool last = (t == nt - 2);
            const char* a1 = cA + (size_t)(t + 1) * kstep;
            const char* a2 = last ? nA : cA + (size_t)(t + 2) * kstep; const char* b2 = last ? nB : cB + (size_t)(t + 2) * kstep;
            const char* a3 = a2 + kstep; const char* b3 = b2 + kstep;
            PG8_LDB(B0, 0, 0); PG8_LDB(B1, 0, 1); PG8_SCHED; PG8_LDA(At, 0, 0); PG8_STAGE(PG8_SA(1, 1), a1 + hstepA, voffA);
            PG8_WAIT_V(8); PG8_WAIT_L(0); PG8_BAR; PG8_MMA(0, 0, At, B0); PG8_MMA(0, 1, At, B1); PG8_BAR; PG8_SCHED;
            PG8_LDA(At, 0, 1); PG8_STAGE(PG8_SB(0, 0), b2, voffB); PG8_STAGE(PG8_SB(0, 1), b2 + hstepB, voffB); PG8_STAGE(PG8_SA(0, 0), a2, voffA);
            PG8_WAIT_V(8); PG8_WAIT_L(0); PG8_BAR; PG8_MMA(1, 0, At, B0); PG8_MMA(1, 1, At, B1); PG8_BAR; PG8_SCHED;
            PG8_LDB(B0, 1, 0); PG8_LDB(B1, 1, 1); PG8_SCHED; PG8_LDA(At, 1, 0); PG8_STAGE(PG8_SA(0, 1), a2 + hstepA, voffA);
            PG8_WAIT_V(8); PG8_WAIT_L(0); PG8_BAR; PG8_MMA(0, 0, At, B0); PG8_MMA(0, 1, At, B1); PG8_BAR; PG8_SCHED;
            PG8_LDA(At, 1, 1); PG8_STAGE(PG8_SB(1, 0), b3, voffB); PG8_STAGE(PG8_SB(1, 1), b3 + hstepB, voffB); PG8_STAGE(PG8_SA(1, 0), a3, voffA);
            PG8_WAIT_V(8); PG8_WAIT_L(0); PG8_BAR; PG8_MMA(1, 0, At, B0); PG8_MMA(1, 1, At, B1); PG8_BAR; PG8_SCHED;
        }
        if (wr == 0) PG8_BAR;
        E(acc, cur, wr, wc, fr, fq);
        if (!has_next) break;
#pragma unroll
        for (int a = 0; a < 2; ++a)
#pragma unroll
            for (int b = 0; b < 2; ++b)
#pragma unroll
                for (int m = 0; m < 4; ++m)
#pragma unroll
                    for (int n = 0; n < 2; ++n) acc[a][b][m][n] = (f32x4){0.f, 0.f, 0.f, 0.f};
        cur = nxt; cA = nA; cB = nB; ++ui;
        if (wr == 1) PG8_BAR;
    }
    PG8_WAIT_V(0);
    PG8_BAR;
#undef PG8_SA
#undef PG8_SB
#undef PG8_STAGE
#undef PG8_LDA
#undef PG8_LDB
#undef PG8_MMA
#undef PG8_WAIT_V
#undef PG8_WAIT_L
#undef PG8_BAR
#undef PG8_SCHED
}
}
using pg8::Unit;
typedef const f32x4 (&AccRef)[2][2][4][2];

__device__ __forceinline__ void st8bf(bf16_t* p, const float* o) { u32x4 w; w.x = pkbf(o[0], o[1]); w.y = pkbf(o[2], o[3]); w.z = pkbf(o[4], o[5]); w.w = pkbf(o[6], o[7]); *(u32x4*)p = w; }
__device__ __forceinline__ void ld8bf(const bf16_t* p, float* o) { const u32x4 w = *(const u32x4*)p; o[0] = bflo(w.x); o[1] = bfhi(w.x); o[2] = bflo(w.y); o[3] = bfhi(w.y); o[4] = bflo(w.z); o[5] = bfhi(w.z); o[6] = bflo(w.w); o[7] = bfhi(w.w); }

struct EpiIn {
    bf16_t *QA, *KVA, *QR, *KR, *VR, *GR;
    __device__ __forceinline__ void operator()(AccRef acc, const Unit& u, int wr, int wc, int fr, int fq) const {
        const int pn = u.pn; bf16_t* base; int ld, c0, mode = 0;
        if (pn < 4) { base = QA; ld = 1024; c0 = pn * 256; }
        else if (pn == 4) { base = KVA; ld = 256; c0 = 0; }
        else if (pn < 9) { base = QR; ld = 1024; c0 = (pn - 5) * 256; mode = 1; }
        else if (pn < 13) { base = KR; ld = 1024; c0 = (pn - 9) * 256; mode = 2; }
        else if (pn < 21) { base = VR; ld = 2048; c0 = (pn - 13) * 256; }
        else { base = GR; ld = 2048; c0 = (pn - 21) * 256; mode = 3; }
        const int row0 = u.pm * 256 + wr * 64 + fr, cl = c0 + wc * 32 + 8 * fq;
        if (mode == 1 || mode == 2) {
            const float sc = (mode == 2) ? 0.0625f : 1.f;
            float th[2][4];
#pragma unroll
            for (int bj = 0; bj < 2; ++bj)
#pragma unroll
                for (int pp = 0; pp < 4; ++pp) { const int pi = 64 * bj + 16 * wc + 4 * fq + pp; th[bj][pp] = fexp2(-(float)pi * (13.287712379549449f / 127.0f)) * 0.15915494309189535f; }
#pragma unroll
            for (int ai = 0; ai < 2; ++ai)
#pragma unroll
                for (int m = 0; m < 4; ++m) { const int row = row0 + ai * 128 + m * 16; const float pos = (float)(row & (SEQ - 1));
#pragma unroll
                    for (int bj = 0; bj < 2; ++bj) { const f32x4 v0 = acc[ai][bj][m][0], v1 = acc[ai][bj][m][1];
                        const float x[8] = {v0[0], v0[1], v0[2], v0[3], v1[0], v1[1], v1[2], v1[3]}; float o[8];
#pragma unroll
                        for (int pp = 0; pp < 4; ++pp) { const float hi = pos * th[bj][pp], lo = __builtin_fmaf(pos, th[bj][pp], -hi); const float rv = __builtin_amdgcn_fractf(hi) + lo;
                            const float s = __builtin_amdgcn_sinf(rv), c = __builtin_amdgcn_cosf(rv);
                            o[2 * pp] = (x[2 * pp] * c - x[2 * pp + 1] * s) * sc; o[2 * pp + 1] = (x[2 * pp + 1] * c + x[2 * pp] * s) * sc; }
                        st8bf(base + (size_t)row * ld + cl + bj * 128, o); } }
        } else {
#pragma unroll
            for (int ai = 0; ai < 2; ++ai)
#pragma unroll
                for (int m = 0; m < 4; ++m) { const int row = row0 + ai * 128 + m * 16;
#pragma unroll
                    for (int bj = 0; bj < 2; ++bj) { const f32x4 v0 = acc[ai][bj][m][0], v1 = acc[ai][bj][m][1];
                        float o[8] = {v0[0], v0[1], v0[2], v0[3], v1[0], v1[1], v1[2], v1[3]};
                        if (mode == 3) {
#pragma unroll
                            for (int e = 0; e < 8; ++e) o[e] = siluf_(o[e]); }
                        st8bf(base + (size_t)row * ld + cl + bj * 128, o); } }
        }
    }
};
template <int ACT> struct EpiBf {
    bf16_t* O; int ld;
    __device__ __forceinline__ void operator()(AccRef acc, const Unit& u, int wr, int wc, int fr, int fq) const {
        const int row0 = u.pm * 256 + wr * 64 + fr, cl = u.pn * 256 + wc * 32 + 8 * fq;
#pragma unroll
        for (int ai = 0; ai < 2; ++ai)
#pragma unroll
            for (int m = 0; m < 4; ++m) { const int row = row0 + ai * 128 + m * 16;
#pragma unroll
                for (int bj = 0; bj < 2; ++bj) { const f32x4 v0 = acc[ai][bj][m][0], v1 = acc[ai][bj][m][1];
                    float o[8] = {v0[0], v0[1], v0[2], v0[3], v1[0], v1[1], v1[2], v1[3]};
                    if (ACT == 1) {
#pragma unroll
                        for (int e = 0; e < 8; ++e) o[e] = sigmoidf_(o[e]); }
                    st8bf(O + (size_t)row * ld + cl + bj * 128, o); } }
    }
};
struct EpiMerge {
    const bf16_t* SZ; bf16_t* BA;
    __device__ __forceinline__ void operator()(AccRef acc, const Unit& u, int wr, int wc, int fr, int fq) const {
        const int row0 = u.pm * 256 + wr * 64 + fr, cl = u.pn * 256 + wc * 32 + 8 * fq;
#pragma unroll
        for (int ai = 0; ai < 2; ++ai)
#pragma unroll
            for (int m = 0; m < 4; ++m) { const int row = row0 + ai * 128 + m * 16;
#pragma unroll
                for (int bj = 0; bj < 2; ++bj) { const f32x4 v0 = acc[ai][bj][m][0], v1 = acc[ai][bj][m][1];
                    const float x[8] = {v0[0], v0[1], v0[2], v0[3], v1[0], v1[1], v1[2], v1[3]};
                    float sa[8], sr[8], ba[8], o[8]; const int c = cl + bj * 128;
                    ld8bf(SZ + (size_t)row * 2048 + c, sa); ld8bf(SZ + (size_t)row * 2048 + 1024 + c, sr); ld8bf(BA + (size_t)row * 1024 + c, ba);
#pragma unroll
                    for (int e = 0; e < 8; ++e) o[e] = sa[e] * ba[e] + sr[e] * x[e];
                    st8bf(BA + (size_t)row * 1024 + c, o); } }
    }
};
struct EpiOut {
    const float* X; const float* G2; float* X1; bf16_t* XN2; float* SS2;
    __device__ __forceinline__ void operator()(AccRef acc, const Unit& u, int wr, int wc, int fr, int fq) const {
        const int row0 = u.pm * 256 + wr * 64 + fr, cl = u.pn * 256 + wc * 32 + 8 * fq;
        f32x4 gg[2][2];
#pragma unroll
        for (int bj = 0; bj < 2; ++bj) { gg[bj][0] = *(const f32x4*)(G2 + cl + bj * 128); gg[bj][1] = *(const f32x4*)(G2 + cl + bj * 128 + 4); }
#pragma unroll
        for (int ai = 0; ai < 2; ++ai)
#pragma unroll
            for (int m = 0; m < 4; ++m) { const int row = row0 + ai * 128 + m * 16; float ss = 0.f;
#pragma unroll
                for (int bj = 0; bj < 2; ++bj) { const size_t off = (size_t)row * 1024 + cl + bj * 128;
                    const f32x4 a0 = *(const f32x4*)(X + off) + acc[ai][bj][m][0], a1 = *(const f32x4*)(X + off + 4) + acc[ai][bj][m][1];
                    *(f32x4*)(X1 + off) = a0; *(f32x4*)(X1 + off + 4) = a1;
                    ss += (a0[0] * a0[0] + a0[1] * a0[1]) + (a0[2] * a0[2] + a0[3] * a0[3]) + (a1[0] * a1[0] + a1[1] * a1[1]) + (a1[2] * a1[2] + a1[3] * a1[3]);
                    const f32x4 b0 = a0 * gg[bj][0], b1 = a1 * gg[bj][1];
                    const float o[8] = {b0[0], b0[1], b0[2], b0[3], b1[0], b1[1], b1[2], b1[3]};
                    st8bf(XN2 + off, o); }
                ss += __shfl_xor(ss, 16); ss += __shfl_xor(ss, 32);
                if (fq == 0) atomicAdd(SS2 + row, ss); }
    }
};
struct EpiGU {
    const float* SS2; bf16_t* H;
    __device__ __forceinline__ void operator()(AccRef acc, const Unit& u, int wr, int wc, int fr, int fq) const {
        const int row0 = u.pm * 256 + wr * 64 + fr, cl = u.pn * 128 + wc * 32 + 8 * fq;
#pragma unroll
        for (int ai = 0; ai < 2; ++ai)
#pragma unroll
            for (int m = 0; m < 4; ++m) { const int row = row0 + ai * 128 + m * 16;
                const float rstd = 1.0f / sqrtf(SS2[row] * (1.0f / 1024.0f) + EPS);
                const f32x4 g0 = acc[ai][0][m][0] * rstd, g1 = acc[ai][0][m][1] * rstd, u0 = acc[ai][1][m][0] * rstd, u1 = acc[ai][1][m][1] * rstd;
                const float gv[8] = {g0[0], g0[1], g0[2], g0[3], g1[0], g1[1], g1[2], g1[3]}, uv[8] = {u0[0], u0[1], u0[2], u0[3], u1[0], u1[1], u1[2], u1[3]}; float o[8];
#pragma unroll
                for (int e = 0; e < 8; ++e) o[e] = siluf_(gv[e]) * uv[e];
                st8bf(H + (size_t)row * DFF + cl, o); }
    }
};
struct EpiDown {
    const float* X1; float* OUT;
    __device__ __forceinline__ void operator()(AccRef acc, const Unit& u, int wr, int wc, int fr, int fq) const {
        const int row0 = u.pm * 256 + wr * 64 + fr, cl = u.pn * 256 + wc * 32 + 8 * fq;
#pragma unroll
        for (int ai = 0; ai < 2; ++ai)
#pragma unroll
            for (int m = 0; m < 4; ++m) { const int row = row0 + ai * 128 + m * 16;
#pragma unroll
                for (int bj = 0; bj < 2; ++bj) { const size_t off = (size_t)row * 1024 + cl + bj * 128;
                    *(f32x4*)(OUT + off) = *(const f32x4*)(X1 + off) + acc[ai][bj][m][0]; *(f32x4*)(OUT + off + 4) = *(const f32x4*)(X1 + off + 4) + acc[ai][bj][m][1]; } }
    }
};

__device__ __forceinline__ void transpose_item(const float* W, int ldw, bf16_t* WT, int ldt, int k0, int n0, int drow, LAS float* scr, int lane) {
#pragma unroll 8
    for (int i = 0; i < 32; ++i) { const int kk = 2 * i + (lane >> 5); scr[kk * 33 + (lane & 31)] = W[(size_t)(k0 + kk) * ldw + n0 + (lane & 31)]; }
    asm volatile("s_waitcnt lgkmcnt(0)" ::: "memory");
    const int c = lane & 7;
#pragma unroll
    for (int j = 0; j < 4; ++j) { const int n = (lane >> 3) + 8 * j; const LAS float* s = scr + (8 * c) * 33 + n;
        u32x4 o; o.x = pkbf(s[0 * 33], s[1 * 33]); o.y = pkbf(s[2 * 33], s[3 * 33]); o.z = pkbf(s[4 * 33], s[5 * 33]); o.w = pkbf(s[6 * 33], s[7 * 33]);
        *(u32x4*)(WT + (size_t)(drow + n) * ldt + k0 + 8 * c) = o; }
    asm volatile("s_waitcnt lgkmcnt(0)" ::: "memory");
}

__device__ __forceinline__ void attn_unit(LAS unsigned char* lds, bf16_t* QA, const bf16_t* KVA, const float* qg, const float* kg, const float* sinks, int b, int n, int kh, int tid) {
    const int lane = tid & 63, w = __builtin_amdgcn_readfirstlane(tid >> 6), g = lane >> 4, li = lane & 15, q4 = li >> 2, p4 = li & 3;
    LAS unsigned char* Kb = lds; LAS unsigned char* Vb = lds + 256 * 144;
    const long tokband = (long)b * SEQ + 128 * (n - 1);
#pragma unroll
    for (int it = 0; it < 4; ++it) { const int id = tid + 512 * it, s = id >> 3, part = id & 7; const bool valid = (n > 0) || (s >= 128);
        u32x4 kv = {0u, 0u, 0u, 0u}, vv = {0u, 0u, 0u, 0u};
        if (valid) { const bf16_t* src = KVA + (size_t)(tokband + s) * 256 + kh * 64 + part * 8; kv = *(const u32x4*)src; vv = *(const u32x4*)(src + 128); }
        float f[8] = {bflo(kv.x), bfhi(kv.x), bflo(kv.y), bfhi(kv.y), bflo(kv.z), bfhi(kv.z), bflo(kv.w), bfhi(kv.w)};
        float ss = 0.f;
#pragma unroll
        for (int e = 0; e < 8; ++e) ss += f[e] * f[e];
        ss += __shfl_xor(ss, 1); ss += __shfl_xor(ss, 2); ss += __shfl_xor(ss, 4);
        const float rstd = 1.0f / sqrtf(ss * (1.0f / 64.0f) + EPS);
        const f32x4 g0 = *(const f32x4*)(kg + part * 8), g1 = *(const f32x4*)(kg + part * 8 + 4);
        u32x4 ko; ko.x = pkbf(f[0] * rstd * g0[0], f[1] * rstd * g0[1]); ko.y = pkbf(f[2] * rstd * g0[2], f[3] * rstd * g0[3]);
        ko.z = pkbf(f[4] * rstd * g1[0], f[5] * rstd * g1[1]); ko.w = pkbf(f[6] * rstd * g1[2], f[7] * rstd * g1[3]);
        *(LAS u32x4*)(Kb + s * 144 + part * 16) = ko; *(LAS u32x4*)(Vb + s * 144 + part * 16) = vv; }
    __syncthreads();
    const int head = kh * 8 + w; const float sink2 = sinks[head] * LOG2E;
    f32x4 qga[2][2];
#pragma unroll
    for (int kk = 0; kk < 2; ++kk) { qga[kk][0] = *(const f32x4*)(qg + 32 * kk + 8 * g); qga[kk][1] = *(const f32x4*)(qg + 32 * kk + 8 * g + 4); }
    for (int sb = 0; sb < 8; ++sb) {
        const int i = 16 * sb + li; const size_t tok = (size_t)b * SEQ + 128 * n + i;
        bf16_t* qp = QA + tok * 1024 + head * 64 + 8 * g;
        const u32x4 q0 = *(const u32x4*)qp, q1 = *(const u32x4*)(qp + 32);
        float f0[8] = {bflo(q0.x), bfhi(q0.x), bflo(q0.y), bfhi(q0.y), bflo(q0.z), bfhi(q0.z), bflo(q0.w), bfhi(q0.w)};
        float f1[8] = {bflo(q1.x), bfhi(q1.x), bflo(q1.y), bfhi(q1.y), bflo(q1.z), bfhi(q1.z), bflo(q1.w), bfhi(q1.w)};
        float ss = 0.f;
#pragma unroll
        for (int e = 0; e < 8; ++e) ss += f0[e] * f0[e] + f1[e] * f1[e];
        ss += __shfl_xor(ss, 16); ss += __shfl_xor(ss, 32);
        const float qs = (1.0f / sqrtf(ss * (1.0f / 64.0f) + EPS)) * (0.125f * LOG2E);
        bf16x8 Qf[2];
        { u32x4 t; t.x = pkbf(f0[0] * qs * qga[0][0][0], f0[1] * qs * qga[0][0][1]); t.y = pkbf(f0[2] * qs * qga[0][0][2], f0[3] * qs * qga[0][0][3]);
          t.z = pkbf(f0[4] * qs * qga[0][1][0], f0[5] * qs * qga[0][1][1]); t.w = pkbf(f0[6] * qs * qga[0][1][2], f0[7] * qs * qga[0][1][3]); Qf[0] = __builtin_bit_cast(bf16x8, t); }
        { u32x4 t; t.x = pkbf(f1[0] * qs * qga[1][0][0], f1[1] * qs * qga[1][0][1]); t.y = pkbf(f1[2] * qs * qga[1][0][2], f1[3] * qs * qga[1][0][3]);
          t.z = pkbf(f1[4] * qs * qga[1][1][0], f1[5] * qs * qga[1][1][1]); t.w = pkbf(f1[6] * qs * qga[1][1][2], f1[7] * qs * qga[1][1][3]); Qf[1] = __builtin_bit_cast(bf16x8, t); }
        const int t0 = sb < 6 ? sb : 6;
        f32x4 sc[10];
#pragma unroll
        for (int tt = 0; tt < 10; ++tt) { LAS unsigned char* kp = Kb + (16 * (t0 + tt) + li) * 144 + 16 * g;
            f32x4 a = (f32x4){0.f, 0.f, 0.f, 0.f}; a = mfma16(ldsrow(kp), Qf[0], a); a = mfma16(ldsrow(kp + 64), Qf[1], a); sc[tt] = a; }
        float mx = sink2;
#pragma unroll
        for (int tt = 0; tt < 10; ++tt)
#pragma unroll
            for (int jj = 0; jj < 4; ++jj) { const int s = 16 * (t0 + tt) + 4 * g + jj; const bool ok = (s > i) && (s <= i + 128) && ((n > 0) || (s >= 128));
                const float v = ok ? sc[tt][jj] : -INFINITY; sc[tt][jj] = v; mx = fmaxf(mx, v); }
        mx = fmaxf(mx, __shfl_xor(mx, 16)); mx = fmaxf(mx, __shfl_xor(mx, 32));
        float l = 0.f;
#pragma unroll
        for (int tt = 0; tt < 10; ++tt)
#pragma unroll
            for (int jj = 0; jj < 4; ++jj) { const float p = fexp2(sc[tt][jj] - mx); sc[tt][jj] = p; l += p; }
        l += __shfl_xor(l, 16); l += __shfl_xor(l, 32); l += fexp2(sink2 - mx);
        const float inv = 1.0f / l;
        bf16x8 Pb[5];
#pragma unroll
        for (int k2 = 0; k2 < 5; ++k2) { u32x4 t; t.x = pkbf(sc[2 * k2][0], sc[2 * k2][1]); t.y = pkbf(sc[2 * k2][2], sc[2 * k2][3]); t.z = pkbf(sc[2 * k2 + 1][0], sc[2 * k2 + 1][1]); t.w = pkbf(sc[2 * k2 + 1][2], sc[2 * k2 + 1][3]); Pb[k2] = __builtin_bit_cast(bf16x8, t); }
#pragma unroll
        for (int dt = 0; dt < 4; ++dt) { f32x4 o = (f32x4){0.f, 0.f, 0.f, 0.f};
#pragma unroll
            for (int k2 = 0; k2 < 5; ++k2) { LAS unsigned char* vp = Vb + (16 * (t0 + 2 * k2) + 4 * g + q4) * 144 + (16 * dt + 4 * p4) * 2;
                o = mfma16(cat8(ldstr(vp), ldstr(vp + 16 * 144)), Pb[k2], o); }
            u32x2 wv; wv.x = pkbf(o[0] * inv, o[1] * inv); wv.y = pkbf(o[2] * inv, o[3] * inv);
            *(u32x2*)(QA + tok * 1024 + head * 64 + 16 * dt + 4 * g) = wv; }
    }
    __syncthreads();
}

constexpr int RK_STRIDE = 528, RV_STRIDE = 144, R_KOFF = 0, R_VOFF = 128 * RK_STRIDE, R_SOFF = R_VOFF + 128 * RV_STRIDE;
__device__ __forceinline__ void ret_unit(LAS unsigned char* lds, const bf16_t* QR, const bf16_t* KR, bf16_t* VR, float* SS, int b, int h, int vs, int tid) {
    const int lane = tid & 63, w = __builtin_amdgcn_readfirstlane(tid >> 6), g = lane >> 4, li = lane & 15, q4 = li >> 2, p4 = li & 3;
    LAS unsigned char* Kl = lds + R_KOFF; LAS unsigned char* Vl = lds + R_VOFF; LAS unsigned char* Sl = lds + R_SOFF;
    const float lg = log2f(1.0f - exp2f(-5.0f - (float)h));
    const int irow = 16 * w + li;
    const float rho = fexp2((float)(irow - 127) * lg), xi = fexp2((float)(irow + 1) * lg), g128 = fexp2(128.0f * lg);
    const float zeta0 = fexp2((float)(127 - (tid >> 3)) * lg), zeta1 = fexp2((float)(127 - 64 - (tid >> 3)) * lg);
    for (int id = tid; id < 64 * RK_STRIDE / 16; id += 512) *(LAS u32x4*)(Sl + id * 16) = (u32x4){0u, 0u, 0u, 0u};
    f32x4 S[2][4];
#pragma unroll
    for (int a = 0; a < 2; ++a)
#pragma unroll
        for (int v = 0; v < 4; ++v) S[a][v] = (f32x4){0.f, 0.f, 0.f, 0.f};
    u32x4 kreg[8], vreg[2]; bf16x8 Qf[8];
#define RET_LOAD_KV(cc) do { const size_t t0_ = (size_t)b * SEQ + 128 * (cc); \
        _Pragma("unroll") for (int it = 0; it < 8; ++it) { const int id = tid + 512 * it, row = id >> 5, part = id & 31; kreg[it] = *(const u32x4*)(KR + (t0_ + row) * 1024 + h * 256 + part * 8); } \
        _Pragma("unroll") for (int it = 0; it < 2; ++it) { const int id = tid + 512 * it, row = id >> 3, part = id & 7; vreg[it] = *(const u32x4*)(VR + (t0_ + row) * 2048 + h * 512 + vs * 64 + part * 8); } } while (0)
#define RET_LOAD_Q(cc) do { const size_t t0_ = (size_t)b * SEQ + 128 * (cc); \
        _Pragma("unroll") for (int kk = 0; kk < 8; ++kk) Qf[kk] = *(const bf16x8*)(QR + (t0_ + irow) * 1024 + h * 256 + 32 * kk + 8 * g); } while (0)
    RET_LOAD_KV(0); RET_LOAD_Q(0);
    for (int c = 0; c < 64; ++c) {
        const size_t tok0 = (size_t)b * SEQ + 128 * c;
        __syncthreads();
#pragma unroll
        for (int it = 0; it < 8; ++it) { const int id = tid + 512 * it, row = id >> 5, part = id & 31; *(LAS u32x4*)(Kl + row * RK_STRIDE + part * 16) = kreg[it]; }
#pragma unroll
        for (int it = 0; it < 2; ++it) { const int id = tid + 512 * it, row = id >> 3, part = id & 7; const float z = it ? zeta1 : zeta0; const u32x4 v = vreg[it];
            u32x4 o; o.x = pkbf(bflo(v.x) * z, bfhi(v.x) * z); o.y = pkbf(bflo(v.y) * z, bfhi(v.y) * z); o.z = pkbf(bflo(v.z) * z, bfhi(v.z) * z); o.w = pkbf(bflo(v.w) * z, bfhi(v.w) * z);
            *(LAS u32x4*)(Vl + row * RV_STRIDE + part * 16) = o; }
        __syncthreads();
        if (c + 1 < 64) RET_LOAD_KV(c + 1);
        f32x4 P[8];
#pragma unroll
        for (int t = 0; t < 8; ++t) { P[t] = (f32x4){0.f, 0.f, 0.f, 0.f};
            if (t <= w) { LAS unsigned char* kp = Kl + (16 * t + li) * RK_STRIDE + 16 * g;
#pragma unroll
                for (int kk = 0; kk < 8; ++kk) P[t] = mfma16(ldsrow(kp + 64 * kk), Qf[kk], P[t]);
                if (t == w) {
#pragma unroll
                    for (int jj = 0; jj < 4; ++jj) if (4 * g + jj > li) P[t][jj] = 0.f; } } }
        bf16x8 Pb[4];
#pragma unroll
        for (int k2 = 0; k2 < 4; ++k2) { u32x4 t; t.x = pkbf(P[2 * k2][0], P[2 * k2][1]); t.y = pkbf(P[2 * k2][2], P[2 * k2][3]); t.z = pkbf(P[2 * k2 + 1][0], P[2 * k2 + 1][1]); t.w = pkbf(P[2 * k2 + 1][2], P[2 * k2 + 1][3]); Pb[k2] = __builtin_bit_cast(bf16x8, t); }
        float ssq = 0.f;
#pragma unroll
        for (int vt = 0; vt < 4; ++vt) { f32x4 a1 = (f32x4){0.f, 0.f, 0.f, 0.f}, a2 = (f32x4){0.f, 0.f, 0.f, 0.f};
#pragma unroll
            for (int k2 = 0; k2 < 4; ++k2) if (2 * k2 <= w) { LAS unsigned char* vp = Vl + (32 * k2 + 4 * g + q4) * RV_STRIDE + (16 * vt + 4 * p4) * 2;
                a1 = mfma16(cat8(ldstr(vp), ldstr(vp + 16 * RV_STRIDE)), Pb[k2], a1); }
            LAS unsigned char* sp = Sl + (16 * vt + li) * RK_STRIDE + 16 * g;
#pragma unroll
            for (int kk = 0; kk < 8; ++kk) a2 = mfma16(ldsrow(sp + 64 * kk), Qf[kk], a2);
            const f32x4 o = a1 * rho + a2 * xi;
            ssq += (o[0] * o[0] + o[1] * o[1]) + (o[2] * o[2] + o[3] * o[3]);
            u32x2 wv; wv.x = pkbf(o[0], o[1]); wv.y = pkbf(o[2], o[3]);
            *(u32x2*)(VR + (tok0 + irow) * 2048 + h * 512 + vs * 64 + 16 * vt + 4 * g) = wv; }
        ssq += __shfl_xor(ssq, 16); ssq += __shfl_xor(ssq, 32);
        if (g == 0) atomicAdd(SS + (tok0 + irow) * 4 + h, ssq);
        if (c + 1 < 64) RET_LOAD_Q(c + 1);
        __syncthreads();
#pragma unroll
        for (int a = 0; a < 2; ++a)
#pragma unroll
            for (int v = 0; v < 4; ++v) S[a][v] = S[a][v] * g128;
#pragma unroll
        for (int kk = 0; kk < 4; ++kk) { bf16x8 Af[2], Bf[4];
#pragma unroll
            for (int a = 0; a < 2; ++a) { LAS unsigned char* kp = Kl + (32 * kk + 8 * g + q4) * RK_STRIDE + (16 * (2 * w + a) + 4 * p4) * 2; Af[a] = cat8(ldstr(kp), ldstr(kp + 4 * RK_STRIDE)); }
#pragma unroll
            for (int v = 0; v < 4; ++v) { LAS unsigned char* vp = Vl + (32 * kk + 8 * g + q4) * RV_STRIDE + (16 * v + 4 * p4) * 2; Bf[v] = cat8(ldstr(vp), ldstr(vp + 4 * RV_STRIDE)); }
#pragma unroll
            for (int a = 0; a < 2; ++a)
#pragma unroll
                for (int v = 0; v < 4; ++v) S[a][v] = mfma16(Af[a], Bf[v], S[a][v]); }
#pragma unroll
        for (int a = 0; a < 2; ++a)
#pragma unroll
            for (int v = 0; v < 4; ++v) { u32x2 wv; wv.x = pkbf(S[a][v][0], S[a][v][1]); wv.y = pkbf(S[a][v][2], S[a][v][3]);
                *(LAS u32x2*)(Sl + (16 * v + li) * RK_STRIDE + (16 * (2 * w + a) + 4 * g) * 2) = wv; }
    }
    __syncthreads();
}

struct Args { const float* in[13]; float* out; unsigned char* ws; int ph_lo, ph_hi, coop, pad; };

__global__ void __launch_bounds__(512, 2) fwd_kernel(Args a) {
    extern __shared__ __attribute__((aligned(16))) unsigned char lds_raw[];
    LAS unsigned char* lds = (LAS unsigned char*)lds_raw;
    cg::grid_group grid = cg::this_grid();
    const int tid = threadIdx.x, lane = tid & 63, wave = __builtin_amdgcn_readfirstlane(tid >> 6);
    const int G = gridDim.x, bid = blockIdx.x;
    const int gw = bid * 8 + wave, NGW = G * 8;
    unsigned char* ws = a.ws;
    const float* x = a.in[0];
    bf16_t* QA = (bf16_t*)(ws + WS_QA); bf16_t* KVA = (bf16_t*)(ws + WS_KVA); bf16_t* QR = (bf16_t*)(ws + WS_QR); bf16_t* KR = (bf16_t*)(ws + WS_KR);
    bf16_t* VR = (bf16_t*)(ws + WS_VR); bf16_t* GR = (bf16_t*)(ws + WS_GR);
    bf16_t* WIN = (bf16_t*)(ws + WS_WIN); bf16_t* WBA = (bf16_t*)(ws + WS_WBA); bf16_t* WBR = (bf16_t*)(ws + WS_WBR); bf16_t* WOUT = (bf16_t*)(ws + WS_WOUT);
    bf16_t* WGU = (bf16_t*)(ws + WS_WGU); bf16_t* WD = (bf16_t*)(ws + WS_WD);
    float* SS = (float*)(ws + WS_SS); float* SS2 = (float*)(ws + WS_SS2);
    bf16_t* SZ = (bf16_t*)(ws + WS_SZ); float* X1 = (float*)(ws + WS_X1); bf16_t* XN2 = (bf16_t*)(ws + WS_XN2); bf16_t* H = (bf16_t*)(ws + WS_H);
    bf16_t* XN = (bf16_t*)((unsigned char*)a.out + OUT_XN); bf16_t* BA = (bf16_t*)((unsigned char*)a.out + OUT_BA);
    const int lo = a.ph_lo, hi = a.ph_hi;
#define IN(k) (lo <= (k) && (k) < hi)
#define SEAM(k) do { if (a.coop && IN(k) && IN((k) + 1)) grid.sync(); } while (0)

    if (IN(0)) {
        LAS float* scr = (LAS float*)(lds + wave * 16384);
        constexpr int I_IN = 16 * (DIN / 32), I_BA = 16 * 32, I_BR = 32 * 32, I_OUT = 16 * 32, I_G = 16 * (DFF / 32), I_D = (DFF / 64) * 32;
        constexpr int NITEMS = I_IN + I_BA + I_BR + I_OUT + 2 * I_G + I_D;
        for (int it = gw; it < NITEMS; it += NGW) {
            int r = it;
            if (r < I_IN) { const int nb = DIN / 32, kb = r / nb, n0 = 32 * (r % nb); transpose_item(a.in[2], DIN, WIN, 1024, 64 * kb, n0, n0, scr, lane); continue; } r -= I_IN;
            if (r < I_BA) { const int kb = r / 32, n0 = 32 * (r % 32); transpose_item(a.in[6], 1024, WBA, 1024, 64 * kb, n0, n0, scr, lane); continue; } r -= I_BA;
            if (r < I_BR) { const int kb = r / 32, n0 = 32 * (r % 32); transpose_item(a.in[7], 1024, WBR, 2048, 64 * kb, n0, n0, scr, lane); continue; } r -= I_BR;
            if (r < I_OUT) { const int kb = r / 32, n0 = 32 * (r % 32); transpose_item(a.in[8], 1024, WOUT, 1024, 64 * kb, n0, n0, scr, lane); continue; } r -= I_OUT;
            if (r < I_G) { const int nb = DFF / 32, kb = r / nb, n0 = 32 * (r % nb); transpose_item(a.in[10], DFF, WGU, 1024, 64 * kb, n0, 256 * (n0 >> 7) + (n0 & 127), scr, lane); continue; } r -= I_G;
            if (r < I_G) { const int nb = DFF / 32, kb = r / nb, n0 = 32 * (r % nb); transpose_item(a.in[11], DFF, WGU, 1024, 64 * kb, n0, 256 * (n0 >> 7) + 128 + (n0 & 127), scr, lane); continue; } r -= I_G;
            { const int kb = r / 32, n0 = 32 * (r % 32); transpose_item(a.in[12], 1024, WD, DFF, 64 * kb, n0, n0, scr, lane); }
        }
        const float* g1 = a.in[1];
        f32x4 gv[4];
#pragma unroll
        for (int j = 0; j < 4; ++j) gv[j] = *(const f32x4*)(g1 + 4 * lane + 256 * j);
        for (int m = gw; m < M_TOK; m += NGW) {
            const f32x4* xr = (const f32x4*)(x + (size_t)m * DM) + lane; f32x4 v[4]; float s = 0.f;
#pragma unroll
            for (int j = 0; j < 4; ++j) { v[j] = xr[64 * j]; s += (v[j][0] * v[j][0] + v[j][1] * v[j][1]) + (v[j][2] * v[j][2] + v[j][3] * v[j][3]); }
            const float rstd = 1.0f / sqrtf(wave_sum(s) * (1.0f / DM) + EPS);
            u32x2* o8 = (u32x2*)(XN + (size_t)m * DM) + lane;
#pragma unroll
            for (int j = 0; j < 4; ++j) { const f32x4 t = v[j] * rstd * gv[j]; u32x2 wv; wv.x = pkbf(t[0], t[1]); wv.y = pkbf(t[2], t[3]); o8[64 * j] = wv; }
        }
        for (int i = bid * 512 + tid; i < M_TOK * 4 / 4; i += G * 512) ((f32x4*)SS)[i] = (f32x4){0.f, 0.f, 0.f, 0.f};
        for (int i = bid * 512 + tid; i < M_TOK / 4; i += G * 512) ((f32x4*)SS2)[i] = (f32x4){0.f, 0.f, 0.f, 0.f};
        __syncthreads();
    }
    SEAM(0);
    if (IN(1)) {
        pg8::Gemm g{XN, WIN, 1024, 1024, M_TOK, N_IN1, 1024}; pg8::StaticOrder S; S.init(M_TOK, N_IN1, G, bid);
        EpiIn E{QA, KVA, QR, KR, VR, GR};
        pg8::gemm_phase(lds, g, S, E);
    }
    SEAM(1);
    if (IN(2)) {
        for (int u = bid; u < 256; u += G) { const int xcd = u & 7, idx = u >> 3, bh = xcd * 4 + (idx >> 3), vs = idx & 7; ret_unit(lds, QR, KR, VR, SS, bh >> 2, bh & 3, vs, tid); }
        for (int u = bid; u < 1024; u += G) attn_unit(lds, QA, KVA, a.in[3], a.in[4], a.in[5], u >> 7, (u >> 1) & 63, u & 1, tid);
    }
    SEAM(2);
    if (IN(3)) {
        for (size_t id = (size_t)bid * 512 + tid; id < (size_t)M_TOK * 256; id += (size_t)G * 512) { const size_t row = id >> 8; const int c8 = (int)(id & 255), h = c8 >> 6;
            const float rstd = 1.0f / sqrtf(SS[row * 4 + h] * (1.0f / 512.0f) + EPS);
            float r[8], gs[8], o[8]; ld8bf(VR + id * 8, r); ld8bf(GR + id * 8, gs);
#pragma unroll
            for (int e = 0; e < 8; ++e) o[e] = r[e] * gs[e] * rstd;
            st8bf(VR + id * 8, o); }
        { pg8::Gemm g{XN, WIN + (size_t)N_IN1 * 1024, 1024, 1024, M_TOK, 2048, 1024}; pg8::StaticOrder S; S.init(M_TOK, 2048, G, bid); EpiBf<1> E{SZ, 2048}; pg8::gemm_phase(lds, g, S, E); }
        { pg8::Gemm g{QA, WBA, 1024, 1024, M_TOK, 1024, 1024}; pg8::StaticOrder S; S.init(M_TOK, 1024, G, bid); EpiBf<0> E{BA, 1024}; pg8::gemm_phase(lds, g, S, E); }
    }
    SEAM(3);
    if (IN(4)) {
        pg8::Gemm g{VR, WBR, 2048, 2048, M_TOK, 1024, 2048}; pg8::StaticOrder S; S.init(M_TOK, 1024, G, bid); EpiMerge E{SZ, BA}; pg8::gemm_phase(lds, g, S, E);
    }
    SEAM(4);
    if (IN(5)) {
        pg8::Gemm g{BA, WOUT, 1024, 1024, M_TOK, 1024, 1024}; pg8::StaticOrder S; S.init(M_TOK, 1024, G, bid); EpiOut E{x, a.in[9], X1, XN2, SS2}; pg8::gemm_phase(lds, g, S, E);
    }
    SEAM(5);
    if (IN(6)) {
        pg8::Gemm g{XN2, WGU, 1024, 1024, M_TOK, 2 * DFF, 1024}; pg8::StaticOrder S; S.init(M_TOK, 2 * DFF, G, bid); EpiGU E{SS2, H}; pg8::gemm_phase(lds, g, S, E);
    }
    SEAM(6);
    if (IN(7)) {
        pg8::Gemm g{H, WD, DFF, DFF, M_TOK, 1024, DFF}; pg8::StaticOrder S; S.init(M_TOK, 1024, G, bid); EpiDown E{X1, a.out}; pg8::gemm_phase(lds, g, S, E);
    }
#undef IN
#undef SEAM
}

#ifndef MK_COOP
#define MK_COOP 1
#endif
extern "C" void kernel_launch(void* const* d_in, const int* in_sizes, int n_in, void* d_out, int out_size, void* d_ws, size_t ws_size, hipStream_t stream) {
    static int grid = 0;
    if (grid == 0) {
        if (n_in != 13 || in_sizes[0] != M_TOK * DM || out_size != M_TOK * DM || ws_size < WS_END) { fprintf(stderr, "kernel_launch: unexpected shapes (n_in %d, in0 %d, out %d, ws %zu)\n", n_in, n_in > 0 ? in_sizes[0] : -1, out_size, ws_size); grid = -1; return; }
        int dev = 0, cus = 0, per_cu = 0;
        hipGetDevice(&dev); hipDeviceGetAttribute(&cus, hipDeviceAttributeMultiprocessorCount, dev);
        if (hipFuncSetAttribute((const void*)fwd_kernel, hipFuncAttributeMaxDynamicSharedMemorySize, LDS_BYTES) != hipSuccess) { fprintf(stderr, "kernel_launch: hipFuncSetAttribute failed\n"); grid = -1; return; }
        if (hipOccupancyMaxActiveBlocksPerMultiprocessor(&per_cu, (const void*)fwd_kernel, 512, LDS_BYTES) != hipSuccess || per_cu < 1) { fprintf(stderr, "kernel_launch: occupancy query says %d\n", per_cu); per_cu = 1; }
        (void)hipGetLastError();
        grid = cus * per_cu; if (grid > 256) grid = 256;
        fprintf(stderr, "kernel_launch: grid %d (cus %d, per_cu %d)\n", grid, cus, per_cu);
    }
    if (grid < 0) return;
    Args a{};
    for (int i = 0; i < 13; ++i) a.in[i] = (const float*)d_in[i];
    a.out = (float*)d_out; a.ws = (unsigned char*)d_ws;
#if MK_COOP
    a.ph_lo = 0; a.ph_hi = 8; a.coop = 1; a.pad = 0;
    void* args[] = {&a};
    hipError_t e = hipLaunchCooperativeKernel((const void*)fwd_kernel, dim3(grid), dim3(512), args, LDS_BYTES, stream);
    if (e != hipSuccess) fprintf(stderr, "cooperative launch failed: %s (grid %d)\n", hipGetErrorString(e), grid);
#else
    for (int p = 0; p < 8; ++p) { a.ph_lo = p; a.ph_hi = p + 1; a.coop = 0; a.pad = 0; hipLaunchKernelGGL(fwd_kernel, dim3(grid), dim3(512), LDS_BYTES, stream, a); }
#endif
}
```

```cpp
#include <hip/hip_runtime.h>
#include <hip/hip_cooperative_groups.h>
#include <cstdio>
#include <cstdint>
namespace cg = cooperative_groups;

#define LAS __attribute__((address_space(3)))
typedef unsigned short bf16_t;
typedef short bf16x8 __attribute__((ext_vector_type(8)));
typedef short s16x4 __attribute__((ext_vector_type(4)));
typedef float f32x4 __attribute__((ext_vector_type(4)));
typedef float f32x2 __attribute__((ext_vector_type(2)));
typedef unsigned u32x4 __attribute__((ext_vector_type(4)));
typedef unsigned u32x2 __attribute__((ext_vector_type(2)));
typedef __bf16 bf16x2_t __attribute__((ext_vector_type(2)));

constexpr int M_TOK = 65536, SEQ = 8192, DM = 1024, DIN = 9472, DFF = 2816;
constexpr int N_IN1 = 7424;
constexpr float EPS = 1e-6f;
constexpr float LOG2E = 1.4426950408889634f;

constexpr size_t MiB = 1u << 20;
constexpr size_t WS_QA = 0, WS_KVA = 128 * MiB, WS_QR = 160 * MiB, WS_KR = 288 * MiB, WS_VR = 416 * MiB, WS_GR = 672 * MiB;
constexpr size_t WS_WIN = 928 * MiB, WS_WBA = 947 * MiB, WS_WBR = 949 * MiB, WS_WOUT = 953 * MiB, WS_WGU = 955 * MiB, WS_WD = 966 * MiB;
constexpr size_t WS_SS = 972 * MiB, WS_SS2 = 973 * MiB, WS_END = 974 * MiB;
constexpr size_t WS_SZ = WS_QR, WS_X1 = WS_GR, WS_XN2 = WS_QA, WS_H = WS_QR;
constexpr size_t OUT_XN = 0, OUT_BA = 128 * MiB;

constexpr int LDS_BYTES = 135168;

__device__ __forceinline__ unsigned pkbf(float lo, float hi) { f32x2 v = {lo, hi}; bf16x2_t b = __builtin_convertvector(v, bf16x2_t); return __builtin_bit_cast(unsigned, b); }
__device__ __forceinline__ float bflo(unsigned u) { return __uint_as_float(u << 16); }
__device__ __forceinline__ float bfhi(unsigned u) { return __uint_as_float(u & 0xffff0000u); }
__device__ __forceinline__ float fexp2(float x) { return __builtin_amdgcn_exp2f(x); }
__device__ __forceinline__ float frcp(float x) { return __builtin_amdgcn_rcpf(x); }
__device__ __forceinline__ float sigmoidf_(float x) { return frcp(1.f + fexp2(-x * LOG2E)); }
__device__ __forceinline__ float siluf_(float x) { return x * sigmoidf_(x); }
__device__ __forceinline__ float wave_sum(float v) {
#pragma unroll
    for (int o = 1; o < 64; o <<= 1) v += __shfl_xor(v, o);
    return v;
}
__device__ __forceinline__ f32x4 mfma16(bf16x8 a, bf16x8 b, f32x4 c) { return __builtin_amdgcn_mfma_f32_16x16x32_bf16(a, b, c, 0, 0, 0); }
__device__ __forceinline__ s16x4 ldstr(LAS unsigned char* p) { return __builtin_bit_cast(s16x4, __builtin_amdgcn_ds_read_tr16_b64_v4i16((LAS s16x4*)p)); }
__device__ __forceinline__ bf16x8 cat8(s16x4 lo, s16x4 hi) { return (bf16x8){lo[0], lo[1], lo[2], lo[3], hi[0], hi[1], hi[2], hi[3]}; }
__device__ __forceinline__ bf16x8 ldsrow(LAS unsigned char* p) { return *(LAS bf16x8*)p; }

namespace pg8 {
constexpr int BM = 256, BK = 64, HALF = 128, HTB = HALF * BK * 2, STAGE_BYTES = 8 * HTB, NXCD = 8, WGM = 8;
__device__ __forceinline__ int lds_byte(int r, int c) { const int st = (r >> 4) * 2 + (c >> 5), rr = r & 15, cc = c & 31, ob = rr * 64 + cc * 2; return st * 1024 + (ob ^ (((ob >> 9) & 1) << 5)); }
__device__ __forceinline__ void stage_rc(int b, int& R, int& C) { const int st = b / 1024, sb = b % 1024, swz = sb ^ (((sb >> 9) & 1) << 5); R = (st >> 1) * 16 + swz / 64; C = (st & 1) * 32 + (swz % 64) / 2; }
__device__ __forceinline__ int perm32(int rho) { const int n = rho >> 4, i = rho & 15; return 8 * (i >> 2) + 4 * n + (i & 3); }

struct Unit { int pm, pn; };
struct Gemm { const bf16_t* A; const bf16_t* Bt; int lda, ldb, M, N, K; };

struct StaticOrder {
    int nM, nN, nwg, G, c;
    __device__ void init(int M, int N, int G_, int c_) { nM = M / BM; nN = N / BM; nwg = nM * nN; G = G_; c = c_; }
    __device__ bool next(int i, Unit& u) const {
        const long L = (long)i * G + c; if (L >= nwg) return false;
        int wgid = (int)L; { const int q = nwg / NXCD, r = nwg % NXCD, xcd = wgid % NXCD, off = wgid / NXCD; wgid = (xcd < r ? xcd * (q + 1) : r * (q + 1) + (xcd - r) * q) + off; }
        const int nig = WGM * nN, gid = wgid / nig, fm = gid * WGM, gsz = (nM - fm) < WGM ? (nM - fm) : WGM;
        u.pm = fm + ((wgid % nig) % gsz); u.pn = (wgid % nig) / gsz; return true;
    }
};

template <class Epi, class Sched, bool HOOK = false>
__device__ __forceinline__ void gemm_phase(LAS unsigned char* lds, const Gemm g, const Sched& S, const Epi& E, const float* hookSS = nullptr) {
    const int tid = threadIdx.x, wid = __builtin_amdgcn_readfirstlane(tid >> 6), lane = tid & 63, wr = wid >> 2, wc = wid & 3, fr = lane & 15, fq = lane >> 4;
    const int K = g.K, nt = K / BK;
    unsigned voffA[2], voffB[2];
#pragma unroll
    for (int i = 0; i < 2; ++i) { int R, C; stage_rc(tid * 16 + i * 8192, R, C); const int Rb = (R & ~31) + perm32(R & 31);
        voffA[i] = (unsigned)(R * g.lda + C) * 2u; voffB[i] = (unsigned)(Rb * g.ldb + C) * 2u; }
    const size_t kstep = (size_t)(BK * 2);
    const size_t hstepA = (size_t)HALF * g.lda * 2, hstepB = (size_t)HALF * g.ldb * 2;
    const size_t tstepA = 2 * hstepA, tstepB = 2 * hstepB;
    const unsigned ldsw = (unsigned)wid * 1024u;
    const int aoff = lds_byte(wr * 64 + fr, fq * 8), boff = lds_byte(wc * 32 + fr, fq * 8);
#define PG8_SA(b, h) (((b) * 2 + (h)) * HTB)
#define PG8_SB(b, h) ((4 + (b) * 2 + (h)) * HTB)
#define PG8_STAGE(bufoff, gbase, voff) do { _Pragma("unroll") for (int _i = 0; _i < 2; ++_i) \
        __builtin_amdgcn_global_load_lds((const unsigned*)((const char*)(gbase) + (voff)[_i]), (LAS unsigned*)(lds + (bufoff) + ldsw + _i * 8192), 16, 0, 0); } while (0)
#define PG8_LDA(dst, b, h) do { _Pragma("unroll") for (int m = 0; m < 4; ++m) _Pragma("unroll") for (int k = 0; k < 2; ++k) dst[m][k] = *(const LAS bf16x8*)(lds + PG8_SA(b, h) + aoff + m * 2048 + k * 1024); } while (0)
#define PG8_LDB(dst, b, h) do { _Pragma("unroll") for (int n = 0; n < 2; ++n) _Pragma("unroll") for (int k = 0; k < 2; ++k) dst[n][k] = *(const LAS bf16x8*)(lds + PG8_SB(b, h) + boff + n * 2048 + k * 1024); } while (0)
#define PG8_MMA(ai, bj, At, Bt) do { __builtin_amdgcn_s_setprio(1); _Pragma("unroll") for (int m = 0; m < 4; ++m) _Pragma("unroll") for (int n = 0; n < 2; ++n) _Pragma("unroll") for (int k = 0; k < 2; ++k) \
        acc[ai][bj][m][n] = __builtin_amdgcn_mfma_f32_16x16x32_bf16(Bt[n][k], At[m][k], acc[ai][bj][m][n], 0, 0, 0); __builtin_amdgcn_s_setprio(0); } while (0)
#define PG8_WAIT_V(n) asm volatile("s_waitcnt vmcnt(" #n ")" ::: "memory")
#define PG8_WAIT_L(n) asm volatile("s_waitcnt lgkmcnt(" #n ")" ::: "memory")
#define PG8_BAR __builtin_amdgcn_s_barrier()
#define PG8_SCHED __builtin_amdgcn_sched_barrier(0)
#define PG8_HOOK(idx) do { const LAS float* tab = (const LAS float*)(lds + STAGE_BYTES) + (idx) * 256 + wr * 64 + fr; \
                _Pragma("unroll") for (int ai = 0; ai < 2; ++ai) _Pragma("unroll") for (int m = 0; m < 4; ++m) { const float f = tab[ai * 128 + m * 16]; \
                    _Pragma("unroll") for (int bj = 0; bj < 2; ++bj) _Pragma("unroll") for (int n = 0; n < 2; ++n) acc[ai][bj][m][n] = acc[ai][bj][m][n] * f; \
                    asm volatile("" ::: "memory"); } } while (0)
    Unit cur, nxt; int ui = 0;
    if (!S.next(0, cur)) return;
    f32x4 acc[2][2][4][2];
#pragma unroll
    for (int a = 0; a < 2; ++a)
#pragma unroll
        for (int b = 0; b < 2; ++b)
#pragma unroll
            for (int m = 0; m < 4; ++m)
#pragma unroll
                for (int n = 0; n < 2; ++n) acc[a][b][m][n] = (f32x4){0.f, 0.f, 0.f, 0.f};
    bf16x8 At[4][2], B0[2][2], B1[2][2];
    const char* cA = (const char*)g.A + (size_t)cur.pm * tstepA; const char* cB = (const char*)g.Bt + (size_t)cur.pn * tstepB;
    PG8_STAGE(PG8_SB(0, 0), cB, voffB); PG8_STAGE(PG8_SB(0, 1), cB + hstepB, voffB); PG8_STAGE(PG8_SA(0, 0), cA, voffA); PG8_STAGE(PG8_SA(0, 1), cA + hstepA, voffA);
    if (wr == 1) PG8_BAR;
    PG8_WAIT_V(2); PG8_BAR;
    PG8_STAGE(PG8_SB(1, 0), cB + kstep, voffB); PG8_STAGE(PG8_SA(1, 0), cA + kstep, voffA); PG8_STAGE(PG8_SB(1, 1), cB + hstepB + kstep, voffB);
    PG8_WAIT_V(6); PG8_BAR;
    for (;;) {
        if constexpr (HOOK) { if (tid >= 256) {
                const int tr_ = tid - 256;
                const f32x4 sv = *(const f32x4*)(hookSS + ((size_t)cur.pm * 256 + tr_) * 4);
                const float m0 = sv[0] * (1.0f / 512.0f) + EPS, m1 = sv[1] * (1.0f / 512.0f) + EPS, m2 = sv[2] * (1.0f / 512.0f) + EPS, m3 = sv[3] * (1.0f / 512.0f) + EPS;
                LAS float* tab = (LAS float*)(lds + STAGE_BYTES);
                tab[tr_] = sqrtf(m1 / m0); tab[256 + tr_] = sqrtf(m2 / m1); tab[512 + tr_] = sqrtf(m3 / m2); tab[768 + tr_] = 1.0f / sqrtf(m3); } }
        const bool has_next = S.next(ui + 1, nxt);
        const char* nA = has_next ? (const char*)g.A + (size_t)nxt.pm * tstepA : cA; const char* nB = has_next ? (const char*)g.Bt + (size_t)nxt.pn * tstepB : cB;
        for (int ts = 0; ts < nt; ts += (HOOK ? 8 : nt)) {
        const int te = HOOK ? ts + 8 : nt;
        if constexpr (HOOK) { if (ts != 0) PG8_HOOK((ts >> 3) - 1); }
        for (int t = ts; t < te; t += 2) {
            const bool last = (t == nt - 2);
            const char* a1 = cA + (size_t)(t + 1) * kstep;
            const char* a2 = last ? nA : cA + (size_t)(t + 2) * kstep; const char* b2 = last ? nB : cB + (size_t)(t + 2) * kstep;
            const char* a3 = a2 + kstep; const char* b3 = b2 + kstep;
            PG8_LDB(B0, 0, 0); PG8_LDB(B1, 0, 1); PG8_SCHED; PG8_LDA(At, 0, 0); PG8_STAGE(PG8_SA(1, 1), a1 + hstepA, voffA);
            PG8_WAIT_V(8); PG8_WAIT_L(0); PG8_BAR; PG8_MMA(0, 0, At, B0); PG8_MMA(0, 1, At, B1); PG8_BAR; PG8_SCHED;
            PG8_LDA(At, 0, 1); PG8_STAGE(PG8_SB(0, 0), b2, voffB); PG8_STAGE(PG8_SB(0, 1), b2 + hstepB, voffB); PG8_STAGE(PG8_SA(0, 0), a2, voffA);
            PG8_WAIT_V(8); PG8_WAIT_L(0); PG8_BAR; PG8_MMA(1, 0, At, B0); PG8_MMA(1, 1, At, B1); PG8_BAR; PG8_SCHED;
            PG8_LDB(B0, 1, 0); PG8_LDB(B1, 1, 1); PG8_SCHED; PG8_LDA(At, 1, 0); PG8_STAGE(PG8_SA(0, 1), a2 + hstepA, voffA);
            PG8_WAIT_V(8); PG8_WAIT_L(0); PG8_BAR; PG8_MMA(0, 0, At, B0); PG8_MMA(0, 1, At, B1); PG8_BAR; PG8_SCHED;
            PG8_LDA(At, 1, 1); PG8_STAGE(PG8_SB(1, 0), b3, voffB); PG8_STAGE(PG8_SB(1, 1), b3 + hstepB, voffB); PG8_STAGE(PG8_SA(1, 0), a3, voffA);
            PG8_WAIT_V(8); PG8_WAIT_L(0); PG8_BAR; PG8_MMA(1, 0, At, B0); PG8_MMA(1, 1, At, B1); PG8_BAR; PG8_SCHED;
        }
        }
        if (wr == 0) PG8_BAR;
        if constexpr (HOOK) PG8_HOOK(3);
        E(acc, cur, wr, wc, fr, fq);
        if (!has_next) break;
#pragma unroll
        for (int a = 0; a < 2; ++a)
#pragma unroll
            for (int b = 0; b < 2; ++b)
#pragma unroll
                for (int m = 0; m < 4; ++m)
#pragma unroll
                    for (int n = 0; n < 2; ++n) acc[a][b][m][n] = (f32x4){0.f, 0.f, 0.f, 0.f};
        cur = nxt; cA = nA; cB = nB; ++ui;
        if (wr == 1) PG8_BAR;
    }
    PG8_WAIT_V(0);
    PG8_BAR;
#undef PG8_SA
#undef PG8_SB
#undef PG8_STAGE
#undef PG8_LDA
#undef PG8_LDB
#undef PG8_MMA
#undef PG8_WAIT_V
#undef PG8_WAIT_L
#undef PG8_BAR
#undef PG8_SCHED
#undef PG8_HOOK
}
}
using pg8::Unit;
typedef const f32x4 (&AccRef)[2][2][4][2];

__device__ __forceinline__ void st8bf(bf16_t* p, const float* o) { u32x4 w; w.x = pkbf(o[0], o[1]); w.y = pkbf(o[2], o[3]); w.z = pkbf(o[4], o[5]); w.w = pkbf(o[6], o[7]); *(u32x4*)p = w; }
__device__ __forceinline__ void ld8bf(const bf16_t* p, float* o) { const u32x4 w = *(const u32x4*)p; o[0] = bflo(w.x); o[1] = bfhi(w.x); o[2] = bflo(w.y); o[3] = bfhi(w.y); o[4] = bflo(w.z); o[5] = bfhi(w.z); o[6] = bflo(w.w); o[7] = bfhi(w.w); }

struct EpiIn {
    bf16_t *QA, *KVA, *QR, *KR, *VR, *GR;
    __device__ __forceinline__ void operator()(AccRef acc, const Unit& u, int wr, int wc, int fr, int fq) const {
        const int pn = u.pn; bf16_t* base; int ld, c0, mode = 0;
        if (pn < 4) { base = QA; ld = 1024; c0 = pn * 256; }
        else if (pn == 4) { base = KVA; ld = 256; c0 = 0; }
        else if (pn < 9) { base = QR; ld = 1024; c0 = (pn - 5) * 256; mode = 1; }
        else if (pn < 13) { base = KR; ld = 1024; c0 = (pn - 9) * 256; mode = 2; }
        else if (pn < 21) { base = VR; ld = 2048; c0 = (pn - 13) * 256; }
        else { base = GR; ld = 2048; c0 = (pn - 21) * 256; mode = 3; }
        const int row0 = u.pm * 256 + wr * 64 + fr, cl = c0 + wc * 32 + 8 * fq;
        if (mode == 1 || mode == 2) {
            const float sc = (mode == 2) ? 0.0625f : 1.f;
            float th[2][4];
#pragma unroll
            for (int bj = 0; bj < 2; ++bj)
#pragma unroll
                for (int pp = 0; pp < 4; ++pp) { const int pi = 64 * bj + 16 * wc + 4 * fq + pp; th[bj][pp] = fexp2(-(float)pi * (13.287712379549449f / 127.0f)) * 0.15915494309189535f; }
#pragma unroll
            for (int ai = 0; ai < 2; ++ai)
#pragma unroll
                for (int m = 0; m < 4; ++m) { const int row = row0 + ai * 128 + m * 16; const float pos = (float)(row & (SEQ - 1));
#pragma unroll
                    for (int bj = 0; bj < 2; ++bj) { const f32x4 v0 = acc[ai][bj][m][0], v1 = acc[ai][bj][m][1];
                        const float x[8] = {v0[0], v0[1], v0[2], v0[3], v1[0], v1[1], v1[2], v1[3]}; float o[8];
#pragma unroll
                        for (int pp = 0; pp < 4; ++pp) { const float hi = pos * th[bj][pp], lo = __builtin_fmaf(pos, th[bj][pp], -hi); const float rv = __builtin_amdgcn_fractf(hi) + lo;
                            const float s = __builtin_amdgcn_sinf(rv), c = __builtin_amdgcn_cosf(rv);
                            o[2 * pp] = (x[2 * pp] * c - x[2 * pp + 1] * s) * sc; o[2 * pp + 1] = (x[2 * pp + 1] * c + x[2 * pp] * s) * sc; }
                        st8bf(base + (size_t)row * ld + cl + bj * 128, o); } }
        } else {
#pragma unroll
            for (int ai = 0; ai < 2; ++ai)
#pragma unroll
                for (int m = 0; m < 4; ++m) { const int row = row0 + ai * 128 + m * 16;
#pragma unroll
                    for (int bj = 0; bj < 2; ++bj) { const f32x4 v0 = acc[ai][bj][m][0], v1 = acc[ai][bj][m][1];
                        float o[8] = {v0[0], v0[1], v0[2], v0[3], v1[0], v1[1], v1[2], v1[3]};
                        if (mode == 3) {
#pragma unroll
                            for (int e = 0; e < 8; ++e) o[e] = siluf_(o[e]); }
                        st8bf(base + (size_t)row * ld + cl + bj * 128, o); } }
        }
    }
};
template <int ACT> struct EpiBf {
    bf16_t* O; int ld;
    __device__ __forceinline__ void operator()(AccRef acc, const Unit& u, int wr, int wc, int fr, int fq) const {
        const int row0 = u.pm * 256 + wr * 64 + fr, cl = u.pn * 256 + wc * 32 + 8 * fq;
#pragma unroll
        for (int ai = 0; ai < 2; ++ai)
#pragma unroll
            for (int m = 0; m < 4; ++m) { const int row = row0 + ai * 128 + m * 16;
#pragma unroll
                for (int bj = 0; bj < 2; ++bj) { const f32x4 v0 = acc[ai][bj][m][0], v1 = acc[ai][bj][m][1];
                    float o[8] = {v0[0], v0[1], v0[2], v0[3], v1[0], v1[1], v1[2], v1[3]};
                    if (ACT == 1) {
#pragma unroll
                        for (int e = 0; e < 8; ++e) o[e] = sigmoidf_(o[e]); }
                    st8bf(O + (size_t)row * ld + cl + bj * 128, o); } }
    }
};
struct EpiMerge {
    const bf16_t* SZ; bf16_t* BA;
    __device__ __forceinline__ void operator()(AccRef acc, const Unit& u, int wr, int wc, int fr, int fq) const {
        const int row0 = u.pm * 256 + wr * 64 + fr, cl = u.pn * 256 + wc * 32 + 8 * fq;
#pragma unroll
        for (int ai = 0; ai < 2; ++ai)
#pragma unroll
            for (int m = 0; m < 4; ++m) { const int row = row0 + ai * 128 + m * 16;
#pragma unroll
                for (int bj = 0; bj < 2; ++bj) { const f32x4 v0 = acc[ai][bj][m][0], v1 = acc[ai][bj][m][1];
                    const float x[8] = {v0[0], v0[1], v0[2], v0[3], v1[0], v1[1], v1[2], v1[3]};
                    float sa[8], sr[8], ba[8], o[8]; const int c = cl + bj * 128;
                    ld8bf(SZ + (size_t)row * 2048 + c, sa); ld8bf(SZ + (size_t)row * 2048 + 1024 + c, sr); ld8bf(BA + (size_t)row * 1024 + c, ba);
#pragma unroll
                    for (int e = 0; e < 8; ++e) o[e] = sa[e] * ba[e] + sr[e] * x[e];
                    st8bf(BA + (size_t)row * 1024 + c, o); }
                asm volatile("" ::: "memory"); }
    }
};
struct EpiOut {
    const float* X; const float* G2; float* X1; bf16_t* XN2; float* SS2;
    __device__ __forceinline__ void operator()(AccRef acc, const Unit& u, int wr, int wc, int fr, int fq) const {
        const int row0 = u.pm * 256 + wr * 64 + fr, cl = u.pn * 256 + wc * 32 + 8 * fq;
        f32x4 gg[2][2];
#pragma unroll
        for (int bj = 0; bj < 2; ++bj) { gg[bj][0] = *(const f32x4*)(G2 + cl + bj * 128); gg[bj][1] = *(const f32x4*)(G2 + cl + bj * 128 + 4); }
#pragma unroll
        for (int ai = 0; ai < 2; ++ai)
#pragma unroll
            for (int m = 0; m < 4; ++m) { const int row = row0 + ai * 128 + m * 16; float ss = 0.f;
#pragma unroll
                for (int bj = 0; bj < 2; ++bj) { const size_t off = (size_t)row * 1024 + cl + bj * 128;
                    const f32x4 a0 = *(const f32x4*)(X + off) + acc[ai][bj][m][0], a1 = *(const f32x4*)(X + off + 4) + acc[ai][bj][m][1];
                    *(f32x4*)(X1 + off) = a0; *(f32x4*)(X1 + off + 4) = a1;
                    ss += (a0[0] * a0[0] + a0[1] * a0[1]) + (a0[2] * a0[2] + a0[3] * a0[3]) + (a1[0] * a1[0] + a1[1] * a1[1]) + (a1[2] * a1[2] + a1[3] * a1[3]);
                    const f32x4 b0 = a0 * gg[bj][0], b1 = a1 * gg[bj][1];
                    const float o[8] = {b0[0], b0[1], b0[2], b0[3], b1[0], b1[1], b1[2], b1[3]};
                    st8bf(XN2 + off, o); }
                ss += __shfl_xor(ss, 16); ss += __shfl_xor(ss, 32);
                if (fq == 0) atomicAdd(SS2 + row, ss); }
    }
};
struct EpiGU {
    const float* SS2; bf16_t* H;
    __device__ __forceinline__ void operator()(AccRef acc, const Unit& u, int wr, int wc, int fr, int fq) const {
        const int row0 = u.pm * 256 + wr * 64 + fr, cl = u.pn * 128 + wc * 32 + 8 * fq;
#pragma unroll
        for (int ai = 0; ai < 2; ++ai)
#pragma unroll
            for (int m = 0; m < 4; ++m) { const int row = row0 + ai * 128 + m * 16;
                const float rstd = 1.0f / sqrtf(SS2[row] * (1.0f / 1024.0f) + EPS);
                const f32x4 g0 = acc[ai][0][m][0] * rstd, g1 = acc[ai][0][m][1] * rstd, u0 = acc[ai][1][m][0] * rstd, u1 = acc[ai][1][m][1] * rstd;
                const float gv[8] = {g0[0], g0[1], g0[2], g0[3], g1[0], g1[1], g1[2], g1[3]}, uv[8] = {u0[0], u0[1], u0[2], u0[3], u1[0], u1[1], u1[2], u1[3]}; float o[8];
#pragma unroll
                for (int e = 0; e < 8; ++e) o[e] = siluf_(gv[e]) * uv[e];
                st8bf(H + (size_t)row * DFF + cl, o); }
    }
};
struct EpiDown {
    const float* X1; float* OUT;
    __device__ __forceinline__ void operator()(AccRef acc, const Unit& u, int wr, int wc, int fr, int fq) const {
        const int row0 = u.pm * 256 + wr * 64 + fr, cl = u.pn * 256 + wc * 32 + 8 * fq;
#pragma unroll
        for (int ai = 0; ai < 2; ++ai)
#pragma unroll
            for (int m = 0; m < 4; ++m) { const int row = row0 + ai * 128 + m * 16;
#pragma unroll
                for (int bj = 0; bj < 2; ++bj) { const size_t off = (size_t)row * 1024 + cl + bj * 128;
                    *(f32x4*)(OUT + off) = *(const f32x4*)(X1 + off) + acc[ai][bj][m][0]; *(f32x4*)(OUT + off + 4) = *(const f32x4*)(X1 + off + 4) + acc[ai][bj][m][1]; } }
    }
};

__device__ __forceinline__ void transpose_item(const float* W, int ldw, bf16_t* WT, int ldt, int k0, int n0, int drow, LAS float* scr, int lane) {
#pragma unroll 8
    for (int i = 0; i < 32; ++i) { const int kk = 2 * i + (lane >> 5); scr[kk * 33 + (lane & 31)] = W[(size_t)(k0 + kk) * ldw + n0 + (lane & 31)]; }
    asm volatile("s_waitcnt lgkmcnt(0)" ::: "memory");
    const int c = lane & 7;
#pragma unroll
    for (int j = 0; j < 4; ++j) { const int n = (lane >> 3) + 8 * j; const LAS float* s = scr + (8 * c) * 33 + n;
        u32x4 o; o.x = pkbf(s[0 * 33], s[1 * 33]); o.y = pkbf(s[2 * 33], s[3 * 33]); o.z = pkbf(s[4 * 33], s[5 * 33]); o.w = pkbf(s[6 * 33], s[7 * 33]);
        *(u32x4*)(WT + (size_t)(drow + n) * ldt + k0 + 8 * c) = o; }
    asm volatile("s_waitcnt lgkmcnt(0)" ::: "memory");
}

__device__ __forceinline__ void attn_unit(LAS unsigned char* lds, bf16_t* QA, const bf16_t* KVA, const float* qg, const float* kg, const float* sinks, int b, int n, int kh, int tid) {
    const int lane = tid & 63, w = __builtin_amdgcn_readfirstlane(tid >> 6), g = lane >> 4, li = lane & 15, q4 = li >> 2, p4 = li & 3;
    LAS unsigned char* Kb = lds; LAS unsigned char* Vb = lds + 256 * 144;
    const long tokband = (long)b * SEQ + 128 * (n - 1);
#pragma unroll
    for (int it = 0; it < 4; ++it) { const int id = tid + 512 * it, s = id >> 3, part = id & 7; const bool valid = (n > 0) || (s >= 128);
        u32x4 kv = {0u, 0u, 0u, 0u}, vv = {0u, 0u, 0u, 0u};
        if (valid) { const bf16_t* src = KVA + (size_t)(tokband + s) * 256 + kh * 64 + part * 8; kv = *(const u32x4*)src; vv = *(const u32x4*)(src + 128); }
        float f[8] = {bflo(kv.x), bfhi(kv.x), bflo(kv.y), bfhi(kv.y), bflo(kv.z), bfhi(kv.z), bflo(kv.w), bfhi(kv.w)};
        float ss = 0.f;
#pragma unroll
        for (int e = 0; e < 8; ++e) ss += f[e] * f[e];
        ss += __shfl_xor(ss, 1); ss += __shfl_xor(ss, 2); ss += __shfl_xor(ss, 4);
        const float rstd = 1.0f / sqrtf(ss * (1.0f / 64.0f) + EPS);
        const f32x4 g0 = *(const f32x4*)(kg + part * 8), g1 = *(const f32x4*)(kg + part * 8 + 4);
        u32x4 ko; ko.x = pkbf(f[0] * rstd * g0[0], f[1] * rstd * g0[1]); ko.y = pkbf(f[2] * rstd * g0[2], f[3] * rstd * g0[3]);
        ko.z = pkbf(f[4] * rstd * g1[0], f[5] * rstd * g1[1]); ko.w = pkbf(f[6] * rstd * g1[2], f[7] * rstd * g1[3]);
        *(LAS u32x4*)(Kb + s * 144 + part * 16) = ko; *(LAS u32x4*)(Vb + s * 144 + part * 16) = vv; }
    __syncthreads();
    const int head = kh * 8 + w; const float sink2 = sinks[head] * LOG2E;
    f32x4 qga[2][2];
#pragma unroll
    for (int kk = 0; kk < 2; ++kk) { qga[kk][0] = *(const f32x4*)(qg + 32 * kk + 8 * g); qga[kk][1] = *(const f32x4*)(qg + 32 * kk + 8 * g + 4); }
    for (int sb = 0; sb < 8; ++sb) {
        const int i = 16 * sb + li; const size_t tok = (size_t)b * SEQ + 128 * n + i;
        bf16_t* qp = QA + tok * 1024 + head * 64 + 8 * g;
        const u32x4 q0 = *(const u32x4*)qp, q1 = *(const u32x4*)(qp + 32);
        float f0[8] = {bflo(q0.x), bfhi(q0.x), bflo(q0.y), bfhi(q0.y), bflo(q0.z), bfhi(q0.z), bflo(q0.w), bfhi(q0.w)};
        float f1[8] = {bflo(q1.x), bfhi(q1.x), bflo(q1.y), bfhi(q1.y), bflo(q1.z), bfhi(q1.z), bflo(q1.w), bfhi(q1.w)};
        float ss = 0.f;
#pragma unroll
        for (int e = 0; e < 8; ++e) ss += f0[e] * f0[e] + f1[e] * f1[e];
        ss += __shfl_xor(ss, 16); ss += __shfl_xor(ss, 32);
        const float qs = (1.0f / sqrtf(ss * (1.0f / 64.0f) + EPS)) * (0.125f * LOG2E);
        bf16x8 Qf[2];
        { u32x4 t; t.x = pkbf(f0[0] * qs * qga[0][0][0], f0[1] * qs * qga[0][0][1]); t.y = pkbf(f0[2] * qs * qga[0][0][2], f0[3] * qs * qga[0][0][3]);
          t.z = pkbf(f0[4] * qs * qga[0][1][0], f0[5] * qs * qga[0][1][1]); t.w = pkbf(f0[6] * qs * qga[0][1][2], f0[7] * qs * qga[0][1][3]); Qf[0] = __builtin_bit_cast(bf16x8, t); }
        { u32x4 t; t.x = pkbf(f1[0] * qs * qga[1][0][0], f1[1] * qs * qga[1][0][1]); t.y = pkbf(f1[2] * qs * qga[1][0][2], f1[3] * qs * qga[1][0][3]);
          t.z = pkbf(f1[4] * qs * qga[1][1][0], f1[5] * qs * qga[1][1][1]); t.w = pkbf(f1[6] * qs * qga[1][1][2], f1[7] * qs * qga[1][1][3]); Qf[1] = __builtin_bit_cast(bf16x8, t); }
        const int t0 = sb < 6 ? sb : 6;
        f32x4 sc[10];
#pragma unroll
        for (int tt = 0; tt < 10; ++tt) { LAS unsigned char* kp = Kb + (16 * (t0 + tt) + li) * 144 + 16 * g;
            f32x4 a = (f32x4){0.f, 0.f, 0.f, 0.f}; a = mfma16(ldsrow(kp), Qf[0], a); a = mfma16(ldsrow(kp + 64), Qf[1], a); sc[tt] = a; }
        float mx = sink2;
#pragma unroll
        for (int tt = 0; tt < 10; ++tt)
#pragma unroll
            for (int jj = 0; jj < 4; ++jj) { const int s = 16 * (t0 + tt) + 4 * g + jj; const bool ok = (s > i) && (s <= i + 128) && ((n > 0) || (s >= 128));
                const float v = ok ? sc[tt][jj] : -INFINITY; sc[tt][jj] = v; mx = fmaxf(mx, v); }
        mx = fmaxf(mx, __shfl_xor(mx, 16)); mx = fmaxf(mx, __shfl_xor(mx, 32));
        float l = 0.f;
#pragma unroll
        for (int tt = 0; tt < 10; ++tt)
#pragma unroll
            for (int jj = 0; jj < 4; ++jj) { const float p = fexp2(sc[tt][jj] - mx); sc[tt][jj] = p; l += p; }
        l += __shfl_xor(l, 16); l += __shfl_xor(l, 32); l += fexp2(sink2 - mx);
        const float inv = 1.0f / l;
        bf16x8 Pb[5];
#pragma unroll
        for (int k2 = 0; k2 < 5; ++k2) { u32x4 t; t.x = pkbf(sc[2 * k2][0], sc[2 * k2][1]); t.y = pkbf(sc[2 * k2][2], sc[2 * k2][3]); t.z = pkbf(sc[2 * k2 + 1][0], sc[2 * k2 + 1][1]); t.w = pkbf(sc[2 * k2 + 1][2], sc[2 * k2 + 1][3]); Pb[k2] = __builtin_bit_cast(bf16x8, t); }
#pragma unroll
        for (int dt = 0; dt < 4; ++dt) { f32x4 o = (f32x4){0.f, 0.f, 0.f, 0.f};
#pragma unroll
            for (int k2 = 0; k2 < 5; ++k2) { LAS unsigned char* vp = Vb + (16 * (t0 + 2 * k2) + 4 * g + q4) * 144 + (16 * dt + 4 * p4) * 2;
                o = mfma16(cat8(ldstr(vp), ldstr(vp + 16 * 144)), Pb[k2], o); }
            u32x2 wv; wv.x = pkbf(o[0] * inv, o[1] * inv); wv.y = pkbf(o[2] * inv, o[3] * inv);
            *(u32x2*)(QA + tok * 1024 + head * 64 + 16 * dt + 4 * g) = wv; }
    }
    __syncthreads();
}

constexpr int RK_STRIDE = 528, RV_STRIDE = 144, R_KOFF = 0, R_VOFF = 128 * RK_STRIDE, R_SOFF = R_VOFF + 128 * RV_STRIDE;
__device__ __forceinline__ void ret_unit(LAS unsigned char* lds, const bf16_t* QR, const bf16_t* KR, bf16_t* VR, const bf16_t* GR, float* SS, int b, int h, int vs, int tid) {
    const int lane = tid & 63, w = __builtin_amdgcn_readfirstlane(tid >> 6), g = lane >> 4, li = lane & 15, q4 = li >> 2, p4 = li & 3;
    LAS unsigned char* Kl = lds + R_KOFF; LAS unsigned char* Vl = lds + R_VOFF; LAS unsigned char* Sl = lds + R_SOFF;
    const float lg = log2f(1.0f - exp2f(-5.0f - (float)h));
    const int irow = 16 * w + li;
    const float rho = fexp2((float)(irow - 127) * lg), xi = fexp2((float)(irow + 1) * lg), g128 = fexp2(128.0f * lg);
    const float zeta0 = fexp2((float)(127 - (tid >> 3)) * lg), zeta1 = fexp2((float)(127 - 64 - (tid >> 3)) * lg);
    for (int id = tid; id < 64 * RK_STRIDE / 16; id += 512) *(LAS u32x4*)(Sl + id * 16) = (u32x4){0u, 0u, 0u, 0u};
    f32x4 S[2][4];
#pragma unroll
    for (int a = 0; a < 2; ++a)
#pragma unroll
        for (int v = 0; v < 4; ++v) S[a][v] = (f32x4){0.f, 0.f, 0.f, 0.f};
    u32x4 kreg[8], vreg[2]; u32x2 greg[4]; bf16x8 Qf[8];
#define RET_LOAD_KV(cc) do { const size_t t0_ = (size_t)b * SEQ + 128 * (cc); \
        _Pragma("unroll") for (int it = 0; it < 8; ++it) { const int id = tid + 512 * it, row = id >> 5, part = id & 31; kreg[it] = *(const u32x4*)(KR + (t0_ + row) * 1024 + h * 256 + part * 8); } \
        _Pragma("unroll") for (int it = 0; it < 2; ++it) { const int id = tid + 512 * it, row = id >> 3, part = id & 7; vreg[it] = *(const u32x4*)(VR + (t0_ + row) * 2048 + h * 512 + vs * 64 + part * 8); } } while (0)
#define RET_LOAD_G(cc) do { const size_t t0_ = (size_t)b * SEQ + 128 * (cc); \
        _Pragma("unroll") for (int vt = 0; vt < 4; ++vt) greg[vt] = *(const u32x2*)(GR + (t0_ + irow) * 2048 + h * 512 + vs * 64 + 16 * vt + 4 * g); } while (0)
#define RET_LOAD_Q(cc) do { const size_t t0_ = (size_t)b * SEQ + 128 * (cc); \
        _Pragma("unroll") for (int kk = 0; kk < 8; ++kk) Qf[kk] = *(const bf16x8*)(QR + (t0_ + irow) * 1024 + h * 256 + 32 * kk + 8 * g); } while (0)
    RET_LOAD_KV(0); RET_LOAD_Q(0);
    for (int c = 0; c < 64; ++c) {
        const size_t tok0 = (size_t)b * SEQ + 128 * c;
        __syncthreads();
#pragma unroll
        for (int it = 0; it < 8; ++it) { const int id = tid + 512 * it, row = id >> 5, part = id & 31; *(LAS u32x4*)(Kl + row * RK_STRIDE + part * 16) = kreg[it]; }
#pragma unroll
        for (int it = 0; it < 2; ++it) { const int id = tid + 512 * it, row = id >> 3, part = id & 7; const float z = it ? zeta1 : zeta0; const u32x4 v = vreg[it];
            u32x4 o; o.x = pkbf(bflo(v.x) * z, bfhi(v.x) * z); o.y = pkbf(bflo(v.y) * z, bfhi(v.y) * z); o.z = pkbf(bflo(v.z) * z, bfhi(v.z) * z); o.w = pkbf(bflo(v.w) * z, bfhi(v.w) * z);
            *(LAS u32x4*)(Vl + row * RV_STRIDE + part * 16) = o; }
        __syncthreads();
        RET_LOAD_G(c);
        if (c + 1 < 64) RET_LOAD_KV(c + 1);
        f32x4 P[8];
#pragma unroll
        for (int t = 0; t < 8; ++t) { P[t] = (f32x4){0.f, 0.f, 0.f, 0.f};
            if (t <= w) { LAS unsigned char* kp = Kl + (16 * t + li) * RK_STRIDE + 16 * g;
#pragma unroll
                for (int kk = 0; kk < 8; ++kk) P[t] = mfma16(ldsrow(kp + 64 * kk), Qf[kk], P[t]);
                if (t == w) {
#pragma unroll
                    for (int jj = 0; jj < 4; ++jj) if (4 * g + jj > li) P[t][jj] = 0.f; } } }
        bf16x8 Pb[4];
#pragma unroll
        for (int k2 = 0; k2 < 4; ++k2) { u32x4 t; t.x = pkbf(P[2 * k2][0], P[2 * k2][1]); t.y = pkbf(P[2 * k2][2], P[2 * k2][3]); t.z = pkbf(P[2 * k2 + 1][0], P[2 * k2 + 1][1]); t.w = pkbf(P[2 * k2 + 1][2], P[2 * k2 + 1][3]); Pb[k2] = __builtin_bit_cast(bf16x8, t); }
        float ssq = 0.f;
#pragma unroll
        for (int vt = 0; vt < 4; ++vt) { f32x4 a1 = (f32x4){0.f, 0.f, 0.f, 0.f}, a2 = (f32x4){0.f, 0.f, 0.f, 0.f};
#pragma unroll
            for (int k2 = 0; k2 < 4; ++k2) if (2 * k2 <= w) { LAS unsigned char* vp = Vl + (32 * k2 + 4 * g + q4) * RV_STRIDE + (16 * vt + 4 * p4) * 2;
                a1 = mfma16(cat8(ldstr(vp), ldstr(vp + 16 * RV_STRIDE)), Pb[k2], a1); }
            LAS unsigned char* sp = Sl + (16 * vt + li) * RK_STRIDE + 16 * g;
#pragma unroll
            for (int kk = 0; kk < 8; ++kk) a2 = mfma16(ldsrow(sp + 64 * kk), Qf[kk], a2);
            const f32x4 o = a1 * rho + a2 * xi;
            ssq += (o[0] * o[0] + o[1] * o[1]) + (o[2] * o[2] + o[3] * o[3]);
            const u32x2 gq = greg[vt];
            u32x2 wv; wv.x = pkbf(o[0] * bflo(gq.x), o[1] * bfhi(gq.x)); wv.y = pkbf(o[2] * bflo(gq.y), o[3] * bfhi(gq.y));
            *(u32x2*)(VR + (tok0 + irow) * 2048 + h * 512 + vs * 64 + 16 * vt + 4 * g) = wv; }
        ssq += __shfl_xor(ssq, 16); ssq += __shfl_xor(ssq, 32);
        if (g == 0) atomicAdd(SS + (tok0 + irow) * 4 + h, ssq);
        if (c + 1 < 64) RET_LOAD_Q(c + 1);
        __syncthreads();
#pragma unroll
        for (int a = 0; a < 2; ++a)
#pragma unroll
            for (int v = 0; v < 4; ++v) S[a][v] = S[a][v] * g128;
#pragma unroll
        for (int kk = 0; kk < 4; ++kk) { bf16x8 Af[2], Bf[4];
#pragma unroll
            for (int a = 0; a < 2; ++a) { LAS unsigned char* kp = Kl + (32 * kk + 8 * g + q4) * RK_STRIDE + (16 * (2 * w + a) + 4 * p4) * 2; Af[a] = cat8(ldstr(kp), ldstr(kp + 4 * RK_STRIDE)); }
#pragma unroll
            for (int v = 0; v < 4; ++v) { LAS unsigned char* vp = Vl + (32 * kk + 8 * g + q4) * RV_STRIDE + (16 * v + 4 * p4) * 2; Bf[v] = cat8(ldstr(vp), ldstr(vp + 4 * RV_STRIDE)); }
#pragma unroll
            for (int a = 0; a < 2; ++a)
#pragma unroll
                for (int v = 0; v < 4; ++v) S[a][v] = mfma16(Af[a], Bf[v], S[a][v]); }
#pragma unroll
        for (int a = 0; a < 2; ++a)
#pragma unroll
            for (int v = 0; v < 4; ++v) { u32x2 wv; wv.x = pkbf(S[a][v][0], S[a][v][1]); wv.y = pkbf(S[a][v][2], S[a][v][3]);
                *(LAS u32x2*)(Sl + (16 * v + li) * RK_STRIDE + (16 * (2 * w + a) + 4 * g) * 2) = wv; }
    }
    __syncthreads();
}

struct Args { const float* in[13]; float* out; unsigned char* ws; int ph_lo, ph_hi, coop, pad; };

__global__ void __launch_bounds__(512, 2) fwd_kernel(Args a) {
    extern __shared__ __attribute__((aligned(16))) unsigned char lds_raw[];
    LAS unsigned char* lds = (LAS unsigned char*)lds_raw;
    cg::grid_group grid = cg::this_grid();
    const int tid = threadIdx.x, lane = tid & 63, wave = __builtin_amdgcn_readfirstlane(tid >> 6);
    const int G = gridDim.x, bid = blockIdx.x;
    const int gw = bid * 8 + wave, NGW = G * 8;
    unsigned char* ws = a.ws;
    const float* x = a.in[0];
    bf16_t* QA = (bf16_t*)(ws + WS_QA); bf16_t* KVA = (bf16_t*)(ws + WS_KVA); bf16_t* QR = (bf16_t*)(ws + WS_QR); bf16_t* KR = (bf16_t*)(ws + WS_KR);
    bf16_t* VR = (bf16_t*)(ws + WS_VR); bf16_t* GR = (bf16_t*)(ws + WS_GR);
    bf16_t* WIN = (bf16_t*)(ws + WS_WIN); bf16_t* WBA = (bf16_t*)(ws + WS_WBA); bf16_t* WBR = (bf16_t*)(ws + WS_WBR); bf16_t* WOUT = (bf16_t*)(ws + WS_WOUT);
    bf16_t* WGU = (bf16_t*)(ws + WS_WGU); bf16_t* WD = (bf16_t*)(ws + WS_WD);
    float* SS = (float*)(ws + WS_SS); float* SS2 = (float*)(ws + WS_SS2);
    bf16_t* SZ = (bf16_t*)(ws + WS_SZ); float* X1 = (float*)(ws + WS_X1); bf16_t* XN2 = (bf16_t*)(ws + WS_XN2); bf16_t* H = (bf16_t*)(ws + WS_H);
    bf16_t* XN = (bf16_t*)((unsigned char*)a.out + OUT_XN); bf16_t* BA = (bf16_t*)((unsigned char*)a.out + OUT_BA);
    const int lo = a.ph_lo, hi = a.ph_hi;
#define IN(k) (lo <= (k) && (k) < hi)
#define SEAM(k) do { if (a.coop && IN(k) && IN((k) + 1)) grid.sync(); } while (0)

    if (IN(0)) {
        LAS float* scr = (LAS float*)(lds + wave * 16384);
        constexpr int I_IN = 16 * (DIN / 32), I_BA = 16 * 32, I_BR = 32 * 32, I_OUT = 16 * 32, I_G = 16 * (DFF / 32), I_D = (DFF / 64) * 32;
        constexpr int NITEMS = I_IN + I_BA + I_BR + I_OUT + 2 * I_G + I_D;
        for (int it = gw; it < NITEMS; it += NGW) {
            int r = it;
            if (r < I_IN) { const int nb = DIN / 32, kb = r / nb, n0 = 32 * (r % nb); transpose_item(a.in[2], DIN, WIN, 1024, 64 * kb, n0, n0, scr, lane); continue; } r -= I_IN;
            if (r < I_BA) { const int kb = r / 32, n0 = 32 * (r % 32); transpose_item(a.in[6], 1024, WBA, 1024, 64 * kb, n0, n0, scr, lane); continue; } r -= I_BA;
            if (r < I_BR) { const int kb = r / 32, n0 = 32 * (r % 32); transpose_item(a.in[7], 1024, WBR, 2048, 64 * kb, n0, n0, scr, lane); continue; } r -= I_BR;
            if (r < I_OUT) { const int kb = r / 32, n0 = 32 * (r % 32); transpose_item(a.in[8], 1024, WOUT, 1024, 64 * kb, n0, n0, scr, lane); continue; } r -= I_OUT;
            if (r < I_G) { const int nb = DFF / 32, kb = r / nb, n0 = 32 * (r % nb); transpose_item(a.in[10], DFF, WGU, 1024, 64 * kb, n0, 256 * (n0 >> 7) + (n0 & 127), scr, lane); continue; } r -= I_G;
            if (r < I_G) { const int nb = DFF / 32, kb = r / nb, n0 = 32 * (r % nb); transpose_item(a.in[11], DFF, WGU, 1024, 64 * kb, n0, 256 * (n0 >> 7) + 128 + (n0 & 127), scr, lane); continue; } r -= I_G;
            { const int kb = r / 32, n0 = 32 * (r % 32); transpose_item(a.in[12], 1024, WD, DFF, 64 * kb, n0, n0, scr, lane); }
        }
        const float* g1 = a.in[1];
        f32x4 gv[4];
#pragma unroll
        for (int j = 0; j < 4; ++j) gv[j] = *(const f32x4*)(g1 + 4 * lane + 256 * j);
        for (int m = gw; m < M_TOK; m += NGW) {
            const f32x4* xr = (const f32x4*)(x + (size_t)m * DM) + lane; f32x4 v[4]; float s = 0.f;
#pragma unroll
            for (int j = 0; j < 4; ++j) { v[j] = xr[64 * j]; s += (v[j][0] * v[j][0] + v[j][1] * v[j][1]) + (v[j][2] * v[j][2] + v[j][3] * v[j][3]); }
            const float rstd = 1.0f / sqrtf(wave_sum(s) * (1.0f / DM) + EPS);
            u32x2* o8 = (u32x2*)(XN + (size_t)m * DM) + lane;
#pragma unroll
            for (int j = 0; j < 4; ++j) { const f32x4 t = v[j] * rstd * gv[j]; u32x2 wv; wv.x = pkbf(t[0], t[1]); wv.y = pkbf(t[2], t[3]); o8[64 * j] = wv; }
        }
        for (int i = bid * 512 + tid; i < M_TOK * 4 / 4; i += G * 512) ((f32x4*)SS)[i] = (f32x4){0.f, 0.f, 0.f, 0.f};
        for (int i = bid * 512 + tid; i < M_TOK / 4; i += G * 512) ((f32x4*)SS2)[i] = (f32x4){0.f, 0.f, 0.f, 0.f};
        __syncthreads();
    }
    SEAM(0);
    if (IN(1)) {
        pg8::Gemm g{XN, WIN, 1024, 1024, M_TOK, N_IN1, 1024}; pg8::StaticOrder S; S.init(M_TOK, N_IN1, G, bid);
        EpiIn E{QA, KVA, QR, KR, VR, GR};
        pg8::gemm_phase(lds, g, S, E);
    }
    SEAM(1);
    if (IN(2)) {
        for (int u = bid; u < 256; u += G) { const int xcd = u & 7, idx = u >> 3, bh = xcd * 4 + (idx >> 3), vs = idx & 7; ret_unit(lds, QR, KR, VR, GR, SS, bh >> 2, bh & 3, vs, tid); }
        for (int u = bid; u < 1024; u += G) attn_unit(lds, QA, KVA, a.in[3], a.in[4], a.in[5], u >> 7, (u >> 1) & 63, u & 1, tid);
    }
    SEAM(2);
    if (IN(3)) {
        { pg8::Gemm g{XN, WIN + (size_t)N_IN1 * 1024, 1024, 1024, M_TOK, 2048, 1024}; pg8::StaticOrder S; S.init(M_TOK, 2048, G, bid); EpiBf<1> E{SZ, 2048}; pg8::gemm_phase(lds, g, S, E); }
        { pg8::Gemm g{QA, WBA, 1024, 1024, M_TOK, 1024, 1024}; pg8::StaticOrder S; S.init(M_TOK, 1024, G, bid); EpiBf<0> E{BA, 1024}; pg8::gemm_phase(lds, g, S, E); }
    }
    SEAM(3);
    if (IN(4)) {
        pg8::Gemm g{VR, WBR, 2048, 2048, M_TOK, 1024, 2048}; pg8::StaticOrder S; S.init(M_TOK, 1024, G, bid); EpiMerge E{SZ, BA}; pg8::gemm_phase<EpiMerge, pg8::StaticOrder, true>(lds, g, S, E, SS);
    }
    SEAM(4);
    if (IN(5)) {
        pg8::Gemm g{BA, WOUT, 1024, 1024, M_TOK, 1024, 1024}; pg8::StaticOrder S; S.init(M_TOK, 1024, G, bid); EpiOut E{x, a.in[9], X1, XN2, SS2}; pg8::gemm_phase(lds, g, S, E);
    }
    SEAM(5);
    if (IN(6)) {
        pg8::Gemm g{XN2, WGU, 1024, 1024, M_TOK, 2 * DFF, 1024}; pg8::StaticOrder S; S.init(M_TOK, 2 * DFF, G, bid); EpiGU E{SS2, H}; pg8::gemm_phase(lds, g, S, E);
    }
    SEAM(6);
    if (IN(7)) {
        pg8::Gemm g{H, WD, DFF, DFF, M_TOK, 1024, DFF}; pg8::StaticOrder S; S.init(M_TOK, 1024, G, bid); EpiDown E{X1, a.out}; pg8::gemm_phase(lds, g, S, E);
    }
#undef IN
#undef SEAM
}

#ifndef MK_COOP
#define MK_COOP 1
#endif
extern "C" void kernel_launch(void* const* d_in, const int* in_sizes, int n_in, void* d_out, int out_size, void* d_ws, size_t ws_size, hipStream_t stream) {
    static int grid = 0;
    if (grid == 0) {
        if (n_in != 13 || in_sizes[0] != M_TOK * DM || out_size != M_TOK * DM || ws_size < WS_END) { fprintf(stderr, "kernel_launch: unexpected shapes (n_in %d, in0 %d, out %d, ws %zu)\n", n_in, n_in > 0 ? in_sizes[0] : -1, out_size, ws_size); grid = -1; return; }
        int dev = 0, cus = 0, per_cu = 0;
        hipGetDevice(&dev); hipDeviceGetAttribute(&cus, hipDeviceAttributeMultiprocessorCount, dev);
        if (hipFuncSetAttribute((const void*)fwd_kernel, hipFuncAttributeMaxDynamicSharedMemorySize, LDS_BYTES) != hipSuccess) { fprintf(stderr, "kernel_launch: hipFuncSetAttribute failed\n"); grid = -1; return; }
        if (hipOccupancyMaxActiveBlocksPerMultiprocessor(&per_cu, (const void*)fwd_kernel, 512, LDS_BYTES) != hipSuccess || per_cu < 1) { fprintf(stderr, "kernel_launch: occupancy query says %d\n", per_cu); per_cu = 1; }
        (void)hipGetLastError();
        grid = cus * per_cu; if (grid > 256) grid = 256;
        fprintf(stderr, "kernel_launch: grid %d (cus %d, per_cu %d)\n", grid, cus, per_cu);
    }
    if (grid < 0) return;
    Args a{};
    for (int i = 0; i < 13; ++i) a.in[i] = (const float*)d_in[i];
    a.out = (float*)d_out; a.ws = (unsigned char*)d_ws;
#if MK_COOP
    a.ph_lo = 0; a.ph_hi = 8; a.coop = 1; a.pad = 0;
    void* args[] = {&a};
    hipError_t e = hipLaunchCooperativeKernel((const void*)fwd_kernel, dim3(grid), dim3(512), args, LDS_BYTES, stream);
    if (e != hipSuccess) fprintf(stderr, "cooperative launch failed: %s (grid %d)\n", hipGetErrorString(e), grid);
#else
    for (int p = 0; p < 8; ++p) { a.ph_lo = p; a.ph_hi = p + 1; a.coop = 0; a.pad = 0; hipLaunchKernelGGL(fwd_kernel, dim3(grid), dim3(512), LDS_BYTES, stream, a); }
#endif
}
```

```cpp
#include <hip/hip_runtime.h>
#include <hip/hip_cooperative_groups.h>
#include <cstdio>
#include <cstdint>
namespace cg = cooperative_groups;

#define LAS __attribute__((address_space(3)))
typedef unsigned short bf16_t;
typedef short bf16x8 __attribute__((ext_vector_type(8)));
typedef short s16x4 __attribute__((ext_vector_type(4)));
typedef float f32x4 __attribute__((ext_vector_type(4)));
typedef float f32x2 __attribute__((ext_vector_type(2)));
typedef unsigned u32x4 __attribute__((ext_vector_type(4)));
typedef unsigned u32x2 __attribute__((ext_vector_type(2)));
typedef __bf16 bf16x2_t __attribute__((ext_vector_type(2)));

constexpr int M_TOK = 65536, SEQ = 8192, DM = 1024, DIN = 9472, DFF = 2816;
constexpr int N_IN1 = 7424;
constexpr float EPS = 1e-6f;
constexpr float LOG2E = 1.4426950408889634f;

constexpr size_t MiB = 1u << 20;
constexpr size_t WS_QA = 0, WS_KVA = 128 * MiB, WS_QR = 160 * MiB, WS_KR = 288 * MiB, WS_VR = 416 * MiB, WS_GR = 672 * MiB;
constexpr size_t WS_WIN = 928 * MiB, WS_WBA = 947 * MiB, WS_WBR = 949 * MiB, WS_WOUT = 953 * MiB, WS_WGU = 955 * MiB, WS_WD = 966 * MiB;
constexpr size_t WS_SS = 972 * MiB, WS_SS2 = 973 * MiB, WS_END = 974 * MiB;
constexpr size_t WS_SZ = WS_QR, WS_X1 = WS_GR, WS_XN2 = WS_QA, WS_H = WS_QR;
constexpr size_t OUT_XN = 0, OUT_BA = 128 * MiB;

constexpr int LDS_BYTES = 155648;

__device__ __forceinline__ unsigned pkbf(float lo, float hi) { f32x2 v = {lo, hi}; bf16x2_t b = __builtin_convertvector(v, bf16x2_t); return __builtin_bit_cast(unsigned, b); }
__device__ __forceinline__ float bflo(unsigned u) { return __uint_as_float(u << 16); }
__device__ __forceinline__ float bfhi(unsigned u) { return __uint_as_float(u & 0xffff0000u); }
__device__ __forceinline__ float fexp2(float x) { return __builtin_amdgcn_exp2f(x); }
__device__ __forceinline__ float frcp(float x) { return __builtin_amdgcn_rcpf(x); }
__device__ __forceinline__ float sigmoidf_(float x) { return frcp(1.f + fexp2(-x * LOG2E)); }
__device__ __forceinline__ float siluf_(float x) { return x * sigmoidf_(x); }
__device__ __forceinline__ float wave_sum(float v) {
#pragma unroll
    for (int o = 1; o < 64; o <<= 1) v += __shfl_xor(v, o);
    return v;
}
__device__ __forceinline__ f32x4 mfma16(bf16x8 a, bf16x8 b, f32x4 c) { return __builtin_amdgcn_mfma_f32_16x16x32_bf16(a, b, c, 0, 0, 0); }
__device__ __forceinline__ s16x4 ldstr(LAS unsigned char* p) { return __builtin_bit_cast(s16x4, __builtin_amdgcn_ds_read_tr16_b64_v4i16((LAS s16x4*)p)); }
__device__ __forceinline__ bf16x8 cat8(s16x4 lo, s16x4 hi) { return (bf16x8){lo[0], lo[1], lo[2], lo[3], hi[0], hi[1], hi[2], hi[3]}; }
__device__ __forceinline__ bf16x8 ldsrow(LAS unsigned char* p) { return *(LAS bf16x8*)p; }

#ifndef PG8_USE_SP2
#define PG8_USE_SP2 1
#endif
namespace pg8 {
constexpr int BM = 256, BK = 64, HALF = 128, HTB = HALF * BK * 2, STAGE_BYTES = 8 * HTB, NXCD = 8, WGM = 4;
__device__ __forceinline__ int lds_byte(int r, int c) { const int st = (r >> 4) * 2 + (c >> 5), rr = r & 15, cc = c & 31, ob = rr * 64 + cc * 2; return st * 1024 + (ob ^ (((ob >> 9) & 1) << 5)); }
__device__ __forceinline__ void stage_rc(int b, int& R, int& C) { const int st = b / 1024, sb = b % 1024, swz = sb ^ (((sb >> 9) & 1) << 5); R = (st >> 1) * 16 + swz / 64; C = (st & 1) * 32 + (swz % 64) / 2; }
__device__ __forceinline__ int perm32(int rho) { const int n = rho >> 4, i = rho & 15; return 8 * (i >> 2) + 4 * n + (i & 3); }

struct Unit { int pm, pn; };
struct Gemm { const bf16_t* A; const bf16_t* Bt; int lda, ldb, M, N, K; };

struct StaticOrder {
    int nM, nN, nwg, G, c, rev;
    __device__ void init(int M, int N, int G_, int c_, int rev_ = 0) { nM = M / BM; nN = N / BM; nwg = nM * nN; G = G_; c = c_; rev = rev_; }
    __device__ bool next(int i, Unit& u) const {
        const long L = (long)i * G + c; if (L >= nwg) return false;
        int wgid = (int)L; { const int q = nwg / NXCD, r = nwg % NXCD, xcd = wgid % NXCD, off = wgid / NXCD; wgid = (xcd < r ? xcd * (q + 1) : r * (q + 1) + (xcd - r) * q) + off; }
        const int nig = WGM * nN, gid = wgid / nig, fm = gid * WGM, gsz = (nM - fm) < WGM ? (nM - fm) : WGM;
        u.pm = fm + ((wgid % nig) % gsz); u.pn = (wgid % nig) / gsz; if (rev) u.pm = nM - 1 - u.pm; return true;
    }
};

template <class Epi, class Sched, bool HOOK = false, bool RSTD = false>
__device__ __forceinline__ void gemm_phase(LAS unsigned char* lds, const Gemm g, const Sched& S, const Epi& E, const float* hookSS = nullptr) {
    const int tid = threadIdx.x, wid = __builtin_amdgcn_readfirstlane(tid >> 6), lane = tid & 63, wr = wid >> 2, wc = wid & 3, fr = lane & 15, fq = lane >> 4;
    const int K = g.K, nt = K / BK;
    unsigned voffA[2], voffB[2];
#pragma unroll
    for (int i = 0; i < 2; ++i) { int R, C; stage_rc(tid * 16 + i * 8192, R, C); const int Rb = (R & ~31) + perm32(R & 31);
        voffA[i] = (unsigned)(R * g.lda + C) * 2u; voffB[i] = (unsigned)(Rb * g.ldb + C) * 2u; }
    const size_t kstep = (size_t)(BK * 2);
    const size_t hstepA = (size_t)HALF * g.lda * 2, hstepB = (size_t)HALF * g.ldb * 2;
    const size_t tstepA = 2 * hstepA, tstepB = 2 * hstepB;
    const unsigned ldsw = (unsigned)wid * 1024u;
    const int aoff = lds_byte(wr * 64 + fr, fq * 8), boff = lds_byte(wc * 32 + fr, fq * 8);
#define PG8_SA(b, h) (((b) * 2 + (h)) * HTB)
#define PG8_SB(b, h) ((4 + (b) * 2 + (h)) * HTB)
#define PG8_STAGE(bufoff, gbase, voff) do { _Pragma("unroll") for (int _i = 0; _i < 2; ++_i) \
        __builtin_amdgcn_global_load_lds((const unsigned*)((const char*)(gbase) + (voff)[_i]), (LAS unsigned*)(lds + (bufoff) + ldsw + _i * 8192), 16, 0, 0); } while (0)
#define PG8_LDA(dst, b, h) do { _Pragma("unroll") for (int m = 0; m < 4; ++m) _Pragma("unroll") for (int k = 0; k < 2; ++k) dst[m][k] = *(const LAS bf16x8*)(lds + PG8_SA(b, h) + aoff + m * 2048 + k * 1024); } while (0)
#define PG8_LDB(dst, b, h) do { _Pragma("unroll") for (int n = 0; n < 2; ++n) _Pragma("unroll") for (int k = 0; k < 2; ++k) dst[n][k] = *(const LAS bf16x8*)(lds + PG8_SB(b, h) + boff + n * 2048 + k * 1024); } while (0)
#define PG8_MMA(ai, bj, At, Bt) do { __builtin_amdgcn_s_setprio(1); _Pragma("unroll") for (int m = 0; m < 4; ++m) _Pragma("unroll") for (int n = 0; n < 2; ++n) _Pragma("unroll") for (int k = 0; k < 2; ++k) \
        acc[ai][bj][m][n] = __builtin_amdgcn_mfma_f32_16x16x32_bf16(Bt[n][k], At[m][k], acc[ai][bj][m][n], 0, 0, 0); __builtin_amdgcn_s_setprio(0); } while (0)
#define PG8_WAIT_V(n) asm volatile("s_waitcnt vmcnt(" #n ")" ::: "memory")
#define PG8_WAIT_L(n) asm volatile("s_waitcnt lgkmcnt(" #n ")" ::: "memory")
#define PG8_BAR __builtin_amdgcn_s_barrier()
#define PG8_SCHED __builtin_amdgcn_sched_barrier(0)
#define PG8_HOOK(idx) do { const LAS float* tab = (const LAS float*)(lds + STAGE_BYTES) + (idx) * 256 + wr * 64 + fr; \
                _Pragma("unroll") for (int ai = 0; ai < 2; ++ai) _Pragma("unroll") for (int m = 0; m < 4; ++m) { const float f = tab[ai * 128 + m * 16]; \
                    _Pragma("unroll") for (int bj = 0; bj < 2; ++bj) _Pragma("unroll") for (int n = 0; n < 2; ++n) acc[ai][bj][m][n] = acc[ai][bj][m][n] * f; \
                    asm volatile("" ::: "memory"); } } while (0)
    Unit cur, nxt; int ui = 0;
    if (!S.next(0, cur)) return;
    f32x4 acc[2][2][4][2];
#pragma unroll
    for (int a = 0; a < 2; ++a)
#pragma unroll
        for (int b = 0; b < 2; ++b)
#pragma unroll
            for (int m = 0; m < 4; ++m)
#pragma unroll
                for (int n = 0; n < 2; ++n) acc[a][b][m][n] = (f32x4){0.f, 0.f, 0.f, 0.f};
    bf16x8 At[4][2], B0[2][2], B1[2][2];
    const char* cA = (const char*)g.A + (size_t)cur.pm * tstepA; const char* cB = (const char*)g.Bt + (size_t)cur.pn * tstepB;
#if PG8_USE_SP2
    PG8_STAGE(PG8_SB(0, 0), cB, voffB); PG8_STAGE(PG8_SB(0, 1), cB + hstepB, voffB); PG8_STAGE(PG8_SA(0, 0), cA, voffA); PG8_STAGE(PG8_SA(0, 1), cA + hstepA, voffA);
    if (wr == 1) PG8_BAR;
    PG8_WAIT_V(2); PG8_BAR;
    PG8_STAGE(PG8_SB(1, 0), cB + kstep, voffB); PG8_STAGE(PG8_SA(1, 0), cA + kstep, voffA); PG8_STAGE(PG8_SB(1, 1), cB + hstepB + kstep, voffB);
    PG8_WAIT_V(6); PG8_BAR;
#else
    PG8_STAGE(PG8_SB(0, 0), cB, voffB); PG8_STAGE(PG8_SA(0, 0), cA, voffA); PG8_STAGE(PG8_SB(0, 1), cB + hstepB, voffB); PG8_STAGE(PG8_SA(0, 1), cA + hstepA, voffA);
    if (wr == 1) PG8_BAR;
    PG8_WAIT_V(4); PG8_BAR;
    PG8_STAGE(PG8_SB(1, 0), cB + kstep, voffB); PG8_STAGE(PG8_SA(1, 0), cA + kstep, voffA); PG8_STAGE(PG8_SB(1, 1), cB + hstepB + kstep, voffB);
    PG8_WAIT_V(6); PG8_BAR;
#endif
    for (;;) {
        if constexpr (HOOK) { if (tid >= 256) {
                const int tr_ = tid - 256;
                const f32x4 sv = *(const f32x4*)(hookSS + ((size_t)cur.pm * 256 + tr_) * 4);
                const float m0 = sv[0] * (1.0f / 512.0f) + EPS, m1 = sv[1] * (1.0f / 512.0f) + EPS, m2 = sv[2] * (1.0f / 512.0f) + EPS, m3 = sv[3] * (1.0f / 512.0f) + EPS;
                LAS float* tab = (LAS float*)(lds + STAGE_BYTES);
                tab[tr_] = sqrtf(m1 / m0); tab[256 + tr_] = sqrtf(m2 / m1); tab[512 + tr_] = sqrtf(m3 / m2); tab[768 + tr_] = 1.0f / sqrtf(m3); } }
        if constexpr (RSTD) { if (tid >= 256) {
                const int tr_ = tid - 256; LAS float* tab = (LAS float*)(lds + STAGE_BYTES);
                tab[tr_] = 1.0f / sqrtf(hookSS[(size_t)cur.pm * 256 + tr_] * (1.0f / 1024.0f) + EPS); } }
        const bool has_next = S.next(ui + 1, nxt);
        const char* nA = has_next ? (const char*)g.A + (size_t)nxt.pm * tstepA : cA; const char* nB = has_next ? (const char*)g.Bt + (size_t)nxt.pn * tstepB : cB;
        for (int ts = 0; ts < nt; ts += (HOOK ? 8 : nt)) {
        const int te = HOOK ? ts + 8 : nt;
        if constexpr (HOOK) { if (ts != 0) PG8_HOOK((ts >> 3) - 1); }
        for (int t = ts; t < te; t += 2) {
            const bool last = (t == nt - 2);
            const char* a1 = cA + (size_t)(t + 1) * kstep;
            const char* a2 = last ? nA : cA + (size_t)(t + 2) * kstep; const char* b2 = last ? nB : cB + (size_t)(t + 2) * kstep;
            const char* a3 = a2 + kstep; const char* b3 = b2 + kstep;
#if PG8_USE_SP2
            PG8_LDB(B0, 0, 0); PG8_LDB(B1, 0, 1); PG8_SCHED; PG8_LDA(At, 0, 0); PG8_STAGE(PG8_SA(1, 1), a1 + hstepA, voffA);
            PG8_WAIT_V(8); PG8_WAIT_L(0); PG8_BAR; PG8_MMA(0, 0, At, B0); PG8_MMA(0, 1, At, B1); PG8_BAR; PG8_SCHED;
            PG8_LDA(At, 0, 1); PG8_STAGE(PG8_SB(0, 0), b2, voffB); PG8_STAGE(PG8_SB(0, 1), b2 + hstepB, voffB); PG8_STAGE(PG8_SA(0, 0), a2, voffA);
            PG8_WAIT_V(8); PG8_WAIT_L(0); PG8_BAR; PG8_MMA(1, 0, At, B0); PG8_MMA(1, 1, At, B1); PG8_BAR; PG8_SCHED;
            PG8_LDB(B0, 1, 0); PG8_LDB(B1, 1, 1); PG8_SCHED; PG8_LDA(At, 1, 0); PG8_STAGE(PG8_SA(0, 1), a2 + hstepA, voffA);
            PG8_WAIT_V(8); PG8_WAIT_L(0); PG8_BAR; PG8_MMA(0, 0, At, B0); PG8_MMA(0, 1, At, B1); PG8_BAR; PG8_SCHED;
            PG8_LDA(At, 1, 1); PG8_STAGE(PG8_SB(1, 0), b3, voffB); PG8_STAGE(PG8_SB(1, 1), b3 + hstepB, voffB); PG8_STAGE(PG8_SA(1, 0), a3, voffA);
            PG8_WAIT_V(8); PG8_WAIT_L(0); PG8_BAR; PG8_MMA(1, 0, At, B0); PG8_MMA(1, 1, At, B1); PG8_BAR; PG8_SCHED;
#else
            PG8_LDB(B0, 0, 0); PG8_SCHED; PG8_LDA(At, 0, 0); PG8_STAGE(PG8_SA(1, 1), a1 + hstepA, voffA);
            PG8_WAIT_L(8); PG8_BAR; PG8_WAIT_L(0); PG8_MMA(0, 0, At, B0); PG8_BAR; PG8_SCHED;
            PG8_LDB(B1, 0, 1); PG8_STAGE(PG8_SB(0, 0), b2, voffB);
            PG8_BAR; PG8_WAIT_L(0); PG8_MMA(0, 1, At, B1); PG8_BAR;
            PG8_LDA(At, 0, 1); PG8_STAGE(PG8_SA(0, 0), a2, voffA);
            PG8_BAR; PG8_WAIT_L(0); PG8_MMA(1, 0, At, B0); PG8_BAR; PG8_SCHED;
            PG8_STAGE(PG8_SB(0, 1), b2 + hstepB, voffB);
            PG8_WAIT_V(6); PG8_BAR; PG8_MMA(1, 1, At, B1); PG8_BAR;
            PG8_LDB(B0, 1, 0); PG8_SCHED; PG8_LDA(At, 1, 0); PG8_STAGE(PG8_SA(0, 1), a2 + hstepA, voffA);
            PG8_WAIT_L(8); PG8_BAR; PG8_WAIT_L(0); PG8_MMA(0, 0, At, B0); PG8_BAR; PG8_SCHED;
            PG8_LDB(B1, 1, 1); PG8_STAGE(PG8_SB(1, 0), b3, voffB);
            PG8_BAR; PG8_WAIT_L(0); PG8_MMA(0, 1, At, B1); PG8_BAR;
            PG8_LDA(At, 1, 1); PG8_STAGE(PG8_SA(1, 0), a3, voffA);
            PG8_BAR; PG8_WAIT_L(0); PG8_MMA(1, 0, At, B0); PG8_BAR; PG8_SCHED;
            PG8_STAGE(PG8_SB(1, 1), b3 + hstepB, voffB);
            PG8_WAIT_V(6); PG8_BAR; PG8_MMA(1, 1, At, B1); PG8_BAR;
#endif
        }
        }
        if (wr == 0) PG8_BAR;
        if constexpr (HOOK) PG8_HOOK(3);
        E(acc, cur, wr, wc, fr, fq);
        if (!has_next) break;
#pragma unroll
        for (int a = 0; a < 2; ++a)
#pragma unroll
            for (int b = 0; b < 2; ++b)
#pragma unroll
                for (int m = 0; m < 4; ++m)
#pragma unroll
                    for (int n = 0; n < 2; ++n) acc[a][b][m][n] = (f32x4){0.f, 0.f, 0.f, 0.f};
        cur = nxt; cA = nA; cB = nB; ++ui;
        if (wr == 1) PG8_BAR;
    }
    PG8_WAIT_V(0);
    PG8_BAR;
#undef PG8_SA
#undef PG8_SB
#undef PG8_STAGE
#undef PG8_LDA
#undef PG8_LDB
#undef PG8_MMA
#undef PG8_WAIT_V
#undef PG8_WAIT_L
#undef PG8_BAR
#undef PG8_SCHED
#undef PG8_HOOK
}
}
using pg8::Unit;
typedef const f32x4 (&AccRef)[2][2][4][2];

__device__ __forceinline__ void st8bf(bf16_t* p, const float* o) { u32x4 w; w.x = pkbf(o[0], o[1]); w.y = pkbf(o[2], o[3]); w.z = pkbf(o[4], o[5]); w.w = pkbf(o[6], o[7]); *(u32x4*)p = w; }
__device__ __forceinline__ void ld8bf(const bf16_t* p, float* o) { const u32x4 w = *(const u32x4*)p; o[0] = bflo(w.x); o[1] = bfhi(w.x); o[2] = bflo(w.y); o[3] = bfhi(w.y); o[4] = bflo(w.z); o[5] = bfhi(w.z); o[6] = bflo(w.w); o[7] = bfhi(w.w); }

struct EpiIn {
    bf16_t *QA, *KVA, *QR, *KR, *VR, *GR;
    __device__ __forceinline__ void operator()(AccRef acc, const Unit& u, int wr, int wc, int fr, int fq) const {
        const int pn = u.pn; bf16_t* base; int ld, c0, mode = 0;
        if (pn < 4) { base = QA; ld = 1024; c0 = pn * 256; }
        else if (pn == 4) { base = KVA; ld = 256; c0 = 0; }
        else if (pn < 9) { base = QR; ld = 1024; c0 = (pn - 5) * 256; mode = 1; }
        else if (pn < 13) { base = KR; ld = 1024; c0 = (pn - 9) * 256; mode = 2; }
        else if (pn < 21) { base = VR; ld = 2048; c0 = (pn - 13) * 256; }
        else { base = GR; ld = 2048; c0 = (pn - 21) * 256; mode = 3; }
        const int row0 = u.pm * 256 + wr * 64 + fr, cl = c0 + wc * 32 + 8 * fq;
        if (mode == 1 || mode == 2) {
            const float sc = (mode == 2) ? 0.0625f : 1.f;
            float th[2][4];
#pragma unroll
            for (int bj = 0; bj < 2; ++bj)
#pragma unroll
                for (int pp = 0; pp < 4; ++pp) { const int pi = 64 * bj + 16 * wc + 4 * fq + pp; th[bj][pp] = fexp2(-(float)pi * (13.287712379549449f / 127.0f)) * 0.15915494309189535f; }
#pragma unroll
            for (int ai = 0; ai < 2; ++ai)
#pragma unroll
                for (int m = 0; m < 4; ++m) { const int row = row0 + ai * 128 + m * 16; const float pos = (float)(row & (SEQ - 1));
#pragma unroll
                    for (int bj = 0; bj < 2; ++bj) { const f32x4 v0 = acc[ai][bj][m][0], v1 = acc[ai][bj][m][1];
                        const float x[8] = {v0[0], v0[1], v0[2], v0[3], v1[0], v1[1], v1[2], v1[3]}; float o[8];
#pragma unroll
                        for (int pp = 0; pp < 4; ++pp) { const float hi = pos * th[bj][pp], lo = __builtin_fmaf(pos, th[bj][pp], -hi); const float rv = __builtin_amdgcn_fractf(hi) + lo;
                            const float s = __builtin_amdgcn_sinf(rv), c = __builtin_amdgcn_cosf(rv);
                            o[2 * pp] = (x[2 * pp] * c - x[2 * pp + 1] * s) * sc; o[2 * pp + 1] = (x[2 * pp + 1] * c + x[2 * pp] * s) * sc; }
                        st8bf(base + (size_t)row * ld + cl + bj * 128, o); } }
        } else {
#pragma unroll
            for (int ai = 0; ai < 2; ++ai)
#pragma unroll
                for (int m = 0; m < 4; ++m) { const int row = row0 + ai * 128 + m * 16;
#pragma unroll
                    for (int bj = 0; bj < 2; ++bj) { const f32x4 v0 = acc[ai][bj][m][0], v1 = acc[ai][bj][m][1];
                        float o[8] = {v0[0], v0[1], v0[2], v0[3], v1[0], v1[1], v1[2], v1[3]};
                        if (mode == 3) {
#pragma unroll
                            for (int e = 0; e < 8; ++e) o[e] = siluf_(o[e]); }
                        st8bf(base + (size_t)row * ld + cl + bj * 128, o); } }
        }
    }
};
template <int ACT> struct EpiBf {
    bf16_t* O; int ld;
    __device__ __forceinline__ void operator()(AccRef acc, const Unit& u, int wr, int wc, int fr, int fq) const {
        const int row0 = u.pm * 256 + wr * 64 + fr, cl = u.pn * 256 + wc * 32 + 8 * fq;
#pragma unroll
        for (int ai = 0; ai < 2; ++ai)
#pragma unroll
            for (int m = 0; m < 4; ++m) { const int row = row0 + ai * 128 + m * 16;
#pragma unroll
                for (int bj = 0; bj < 2; ++bj) { const f32x4 v0 = acc[ai][bj][m][0], v1 = acc[ai][bj][m][1];
                    float o[8] = {v0[0], v0[1], v0[2], v0[3], v1[0], v1[1], v1[2], v1[3]};
                    if (ACT == 1) {
#pragma unroll
                        for (int e = 0; e < 8; ++e) o[e] = sigmoidf_(o[e]); }
                    st8bf(O + (size_t)row * ld + cl + bj * 128, o); } }
    }
};
struct EpiSig8 {
    unsigned char* O;
    __device__ __forceinline__ void operator()(AccRef acc, const Unit& u, int wr, int wc, int fr, int fq) const {
        const int row0 = u.pm * 256 + wr * 64 + fr, cl = u.pn * 256 + wc * 32 + 8 * fq;
#pragma unroll
        for (int ai = 0; ai < 2; ++ai)
#pragma unroll
            for (int m = 0; m < 4; ++m) { const int row = row0 + ai * 128 + m * 16;
#pragma unroll
                for (int bj = 0; bj < 2; ++bj) { const f32x4 v0 = acc[ai][bj][m][0], v1 = acc[ai][bj][m][1];
                    const float o[8] = {v0[0], v0[1], v0[2], v0[3], v1[0], v1[1], v1[2], v1[3]}; unsigned q[8];
#pragma unroll
                    for (int e = 0; e < 8; ++e) q[e] = (unsigned)(sigmoidf_(o[e]) * 255.0f + 0.5f);
                    u32x2 w; w.x = q[0] | (q[1] << 8) | (q[2] << 16) | (q[3] << 24); w.y = q[4] | (q[5] << 8) | (q[6] << 16) | (q[7] << 24);
                    *(u32x2*)(O + (size_t)row * 2048 + cl + bj * 128) = w; } }
    }
};
struct EpiMerge {
    const unsigned char* __restrict__ SZ; bf16_t* BA;
    __device__ __forceinline__ void operator()(AccRef acc, const Unit& u, int wr, int wc, int fr, int fq) const {
        const int row0 = u.pm * 256 + wr * 64 + fr, cl = u.pn * 256 + wc * 32 + 8 * fq;
#pragma unroll
        for (int ai = 0; ai < 2; ++ai)
#pragma unroll
            for (int mp = 0; mp < 2; ++mp) { u32x2 wa[2][2], wr_[2][2]; u32x4 wb[2][2];
#pragma unroll
                for (int mm = 0; mm < 2; ++mm)
#pragma unroll
                    for (int bj = 0; bj < 2; ++bj) { const size_t row = (size_t)(row0 + ai * 128 + (2 * mp + mm) * 16); const int c = cl + bj * 128;
                        wa[mm][bj] = *(const u32x2*)(SZ + row * 2048 + c); wr_[mm][bj] = *(const u32x2*)(SZ + row * 2048 + 1024 + c); wb[mm][bj] = *(const u32x4*)(BA + row * 1024 + c); }
#pragma unroll
                for (int mm = 0; mm < 2; ++mm)
#pragma unroll
                    for (int bj = 0; bj < 2; ++bj) { const int m = 2 * mp + mm; const size_t row = (size_t)(row0 + ai * 128 + m * 16); const int c = cl + bj * 128;
                        const f32x4 v0 = acc[ai][bj][m][0], v1 = acc[ai][bj][m][1]; const u32x2 A_ = wa[mm][bj], R_ = wr_[mm][bj]; const u32x4 B_ = wb[mm][bj];
                        const float k = 1.0f / 255.0f;
                        const float sa[8] = {(float)(A_.x & 255u) * k, (float)((A_.x >> 8) & 255u) * k, (float)((A_.x >> 16) & 255u) * k, (float)(A_.x >> 24) * k, (float)(A_.y & 255u) * k, (float)((A_.y >> 8) & 255u) * k, (float)((A_.y >> 16) & 255u) * k, (float)(A_.y >> 24) * k};
                        const float sr[8] = {(float)(R_.x & 255u) * k, (float)((R_.x >> 8) & 255u) * k, (float)((R_.x >> 16) & 255u) * k, (float)(R_.x >> 24) * k, (float)(R_.y & 255u) * k, (float)((R_.y >> 8) & 255u) * k, (float)((R_.y >> 16) & 255u) * k, (float)(R_.y >> 24) * k};
                        u32x4 o;
                        o.x = pkbf(sa[0] * bflo(B_.x) + sr[0] * v0[0], sa[1] * bfhi(B_.x) + sr[1] * v0[1]);
                        o.y = pkbf(sa[2] * bflo(B_.y) + sr[2] * v0[2], sa[3] * bfhi(B_.y) + sr[3] * v0[3]);
                        o.z = pkbf(sa[4] * bflo(B_.z) + sr[4] * v1[0], sa[5] * bfhi(B_.z) + sr[5] * v1[1]);
                        o.w = pkbf(sa[6] * bflo(B_.w) + sr[6] * v1[2], sa[7] * bfhi(B_.w) + sr[7] * v1[3]);
                        *(u32x4*)(BA + row * 1024 + c) = o; } }
    }
};
struct EpiOut {
    const float* __restrict__ X; const float* __restrict__ G2; bf16_t* __restrict__ X1; bf16_t* __restrict__ XN2; float* __restrict__ SS2;
    __device__ __forceinline__ void operator()(AccRef acc, const Unit& u, int wr, int wc, int fr, int fq) const {
        const int row0 = u.pm * 256 + wr * 64 + fr, cl = u.pn * 256 + wc * 32 + 8 * fq;
        f32x4 gg[2][2];
#pragma unroll
        for (int bj = 0; bj < 2; ++bj) { gg[bj][0] = *(const f32x4*)(G2 + cl + bj * 128); gg[bj][1] = *(const f32x4*)(G2 + cl + bj * 128 + 4); }
#pragma unroll
        for (int ai = 0; ai < 2; ++ai) { f32x4 xv[4][2][2];
#pragma unroll
            for (int m = 0; m < 4; ++m)
#pragma unroll
                for (int bj = 0; bj < 2; ++bj) { const size_t off = (size_t)(row0 + ai * 128 + m * 16) * 1024 + cl + bj * 128; xv[m][bj][0] = *(const f32x4*)(X + off); xv[m][bj][1] = *(const f32x4*)(X + off + 4); }
#pragma unroll
            for (int m = 0; m < 4; ++m) { const int row = row0 + ai * 128 + m * 16; float ss = 0.f;
#pragma unroll
                for (int bj = 0; bj < 2; ++bj) { const size_t off = (size_t)row * 1024 + cl + bj * 128;
                    const f32x4 a0 = xv[m][bj][0] + acc[ai][bj][m][0], a1 = xv[m][bj][1] + acc[ai][bj][m][1];
                    { const float xo[8] = {a0[0], a0[1], a0[2], a0[3], a1[0], a1[1], a1[2], a1[3]}; st8bf(X1 + off, xo); }
                    ss += (a0[0] * a0[0] + a0[1] * a0[1]) + (a0[2] * a0[2] + a0[3] * a0[3]) + (a1[0] * a1[0] + a1[1] * a1[1]) + (a1[2] * a1[2] + a1[3] * a1[3]);
                    const f32x4 b0 = a0 * gg[bj][0], b1 = a1 * gg[bj][1];
                    const float o[8] = {b0[0], b0[1], b0[2], b0[3], b1[0], b1[1], b1[2], b1[3]};
                    st8bf(XN2 + off, o); }
                ss += __shfl_xor(ss, 16); ss += __shfl_xor(ss, 32);
                if (fq == 0) atomicAdd(SS2 + row, ss); } }
    }
};
struct EpiGU {
    LAS const float* TAB; bf16_t* H;
    __device__ __forceinline__ void operator()(AccRef acc, const Unit& u, int wr, int wc, int fr, int fq) const {
        const int row0 = u.pm * 256 + wr * 64 + fr, cl = u.pn * 128 + wc * 32 + 8 * fq;
#pragma unroll
        for (int ai = 0; ai < 2; ++ai)
#pragma unroll
            for (int m = 0; m < 4; ++m) { const int row = row0 + ai * 128 + m * 16;
                const float rstd = TAB[ai * 128 + wr * 64 + m * 16 + fr];
                const f32x4 g0 = acc[ai][0][m][0] * rstd, g1 = acc[ai][0][m][1] * rstd, u0 = acc[ai][1][m][0] * rstd, u1 = acc[ai][1][m][1] * rstd;
                const float gv[8] = {g0[0], g0[1], g0[2], g0[3], g1[0], g1[1], g1[2], g1[3]}, uv[8] = {u0[0], u0[1], u0[2], u0[3], u1[0], u1[1], u1[2], u1[3]}; float o[8];
#pragma unroll
                for (int e = 0; e < 8; ++e) o[e] = siluf_(gv[e]) * uv[e];
                st8bf(H + (size_t)row * DFF + cl, o); }
    }
};
struct EpiDown {
    const bf16_t* __restrict__ X1; float* __restrict__ OUT;
    __device__ __forceinline__ void operator()(AccRef acc, const Unit& u, int wr, int wc, int fr, int fq) const {
        const int row0 = u.pm * 256 + wr * 64 + fr, cl = u.pn * 256 + wc * 32 + 8 * fq;
#pragma unroll
        for (int ai = 0; ai < 2; ++ai) { u32x4 xv[4][2];
#pragma unroll
            for (int m = 0; m < 4; ++m)
#pragma unroll
                for (int bj = 0; bj < 2; ++bj) { const size_t off = (size_t)(row0 + ai * 128 + m * 16) * 1024 + cl + bj * 128; xv[m][bj] = *(const u32x4*)(X1 + off); }
#pragma unroll
            for (int m = 0; m < 4; ++m)
#pragma unroll
                for (int bj = 0; bj < 2; ++bj) { const size_t off = (size_t)(row0 + ai * 128 + m * 16) * 1024 + cl + bj * 128; const u32x4 w = xv[m][bj];
                    const f32x4 x0 = {bflo(w.x), bfhi(w.x), bflo(w.y), bfhi(w.y)}, x1 = {bflo(w.z), bfhi(w.z), bflo(w.w), bfhi(w.w)};
                    *(f32x4*)(OUT + off) = x0 + acc[ai][bj][m][0]; *(f32x4*)(OUT + off + 4) = x1 + acc[ai][bj][m][1]; } }
    }
};

__device__ __forceinline__ void transpose_item(const float* W, int ldw, bf16_t* WT, int ldt, int k0, int n0, int drow, LAS float* scr, int lane) {
    float wv[32];
#pragma unroll
    for (int i = 0; i < 32; ++i) { const int kk = 2 * i + (lane >> 5); wv[i] = W[(size_t)(k0 + kk) * ldw + n0 + (lane & 31)]; }
#pragma unroll
    for (int i = 0; i < 32; ++i) { const int kk = 2 * i + (lane >> 5); scr[kk * 33 + (lane & 31)] = wv[i]; }
    asm volatile("s_waitcnt lgkmcnt(0)" ::: "memory");
    const int c = lane & 7;
#pragma unroll
    for (int j = 0; j < 4; ++j) { const int n = (lane >> 3) + 8 * j; const LAS float* s = scr + (8 * c) * 33 + n;
        u32x4 o; o.x = pkbf(s[0 * 33], s[1 * 33]); o.y = pkbf(s[2 * 33], s[3 * 33]); o.z = pkbf(s[4 * 33], s[5 * 33]); o.w = pkbf(s[6 * 33], s[7 * 33]);
        *(u32x4*)(WT + (size_t)(drow + n) * ldt + k0 + 8 * c) = o; }
    asm volatile("s_waitcnt lgkmcnt(0)" ::: "memory");
}

__device__ __forceinline__ void attn_load(const bf16_t* KVA, int b, int n, int kh, int tid, u32x4 (&kvr)[4], u32x4 (&vvr)[4]) {
    const long tokband = (long)b * SEQ + 128 * (n - 1);
#pragma unroll
    for (int it = 0; it < 4; ++it) { const int id = tid + 512 * it, s = id >> 3, part = id & 7; const bool valid = (n > 0) || (s >= 128);
        kvr[it] = (u32x4){0u, 0u, 0u, 0u}; vvr[it] = (u32x4){0u, 0u, 0u, 0u};
        if (valid) { const bf16_t* src = KVA + (size_t)(tokband + s) * 256 + kh * 64 + part * 8; kvr[it] = *(const u32x4*)src; vvr[it] = *(const u32x4*)(src + 128); } }
}
__device__ __forceinline__ void attn_unit(LAS unsigned char* lds, bf16_t* QA, const bf16_t* KVA, const float* qg, const float* kg, const float* sinks, int b, int n, int kh, int tid, u32x4 (&kvr)[4], u32x4 (&vvr)[4], int un) {
    const int lane = tid & 63, w = __builtin_amdgcn_readfirstlane(tid >> 6), g = lane >> 4, li = lane & 15, q4 = li >> 2, p4 = li & 3;
    LAS unsigned char* Kb = lds; LAS unsigned char* Vb = lds + 256 * 144;
#pragma unroll
    for (int it = 0; it < 4; ++it) { const int id = tid + 512 * it, s = id >> 3, part = id & 7;
        const u32x4 kv = kvr[it], vv = vvr[it];
        float f[8] = {bflo(kv.x), bfhi(kv.x), bflo(kv.y), bfhi(kv.y), bflo(kv.z), bfhi(kv.z), bflo(kv.w), bfhi(kv.w)};
        float ss = 0.f;
#pragma unroll
        for (int e = 0; e < 8; ++e) ss += f[e] * f[e];
        ss += __shfl_xor(ss, 1); ss += __shfl_xor(ss, 2); ss += __shfl_xor(ss, 4);
        const float rstd = 1.0f / sqrtf(ss * (1.0f / 64.0f) + EPS);
        const f32x4 g0 = *(const f32x4*)(kg + part * 8), g1 = *(const f32x4*)(kg + part * 8 + 4);
        u32x4 ko; ko.x = pkbf(f[0] * rstd * g0[0], f[1] * rstd * g0[1]); ko.y = pkbf(f[2] * rstd * g0[2], f[3] * rstd * g0[3]);
        ko.z = pkbf(f[4] * rstd * g1[0], f[5] * rstd * g1[1]); ko.w = pkbf(f[6] * rstd * g1[2], f[7] * rstd * g1[3]);
        *(LAS u32x4*)(Kb + s * 144 + part * 16) = ko; *(LAS u32x4*)(Vb + s * 144 + part * 16) = vv; }
    __syncthreads();
    if (un < 1024) attn_load(KVA, un >> 7, (un >> 1) & 63, un & 1, tid, kvr, vvr);
    const int head = kh * 8 + w; const float sink2 = sinks[head] * LOG2E;
    f32x4 qga[2][2];
#pragma unroll
    for (int kk = 0; kk < 2; ++kk) { qga[kk][0] = *(const f32x4*)(qg + 32 * kk + 8 * g); qga[kk][1] = *(const f32x4*)(qg + 32 * kk + 8 * g + 4); }
    bf16_t* const qp0 = QA + ((size_t)b * SEQ + 128 * n + li) * 1024 + head * 64 + 8 * g;
    u32x4 q0n = *(const u32x4*)qp0, q1n = *(const u32x4*)(qp0 + 32);
    for (int sb = 0; sb < 8; ++sb) {
        const int i = 16 * sb + li; const size_t tok = (size_t)b * SEQ + 128 * n + i;
        const u32x4 q0 = q0n, q1 = q1n;
        if (sb + 1 < 8) { q0n = *(const u32x4*)(qp0 + (size_t)(sb + 1) * 16 * 1024); q1n = *(const u32x4*)(qp0 + (size_t)(sb + 1) * 16 * 1024 + 32); }
        float f0[8] = {bflo(q0.x), bfhi(q0.x), bflo(q0.y), bfhi(q0.y), bflo(q0.z), bfhi(q0.z), bflo(q0.w), bfhi(q0.w)};
        float f1[8] = {bflo(q1.x), bfhi(q1.x), bflo(q1.y), bfhi(q1.y), bflo(q1.z), bfhi(q1.z), bflo(q1.w), bfhi(q1.w)};
        float ss = 0.f;
#pragma unroll
        for (int e = 0; e < 8; ++e) ss += f0[e] * f0[e] + f1[e] * f1[e];
        ss += __shfl_xor(ss, 16); ss += __shfl_xor(ss, 32);
        const float qs = (1.0f / sqrtf(ss * (1.0f / 64.0f) + EPS)) * (0.125f * LOG2E);
        bf16x8 Qf[2];
        { u32x4 t; t.x = pkbf(f0[0] * qs * qga[0][0][0], f0[1] * qs * qga[0][0][1]); t.y = pkbf(f0[2] * qs * qga[0][0][2], f0[3] * qs * qga[0][0][3]);
          t.z = pkbf(f0[4] * qs * qga[0][1][0], f0[5] * qs * qga[0][1][1]); t.w = pkbf(f0[6] * qs * qga[0][1][2], f0[7] * qs * qga[0][1][3]); Qf[0] = __builtin_bit_cast(bf16x8, t); }
        { u32x4 t; t.x = pkbf(f1[0] * qs * qga[1][0][0], f1[1] * qs * qga[1][0][1]); t.y = pkbf(f1[2] * qs * qga[1][0][2], f1[3] * qs * qga[1][0][3]);
          t.z = pkbf(f1[4] * qs * qga[1][1][0], f1[5] * qs * qga[1][1][1]); t.w = pkbf(f1[6] * qs * qga[1][1][2], f1[7] * qs * qga[1][1][3]); Qf[1] = __builtin_bit_cast(bf16x8, t); }
        f32x4 sc[9];
#pragma unroll
        for (int tt = 0; tt < 9; ++tt) { LAS unsigned char* kp = Kb + (16 * (sb + tt) + li) * 144 + 16 * g;
            f32x4 a_ = (f32x4){0.f, 0.f, 0.f, 0.f}; a_ = mfma16(ldsrow(kp), Qf[0], a_); a_ = mfma16(ldsrow(kp + 64), Qf[1], a_); sc[tt] = a_; }
#pragma unroll
        for (int jj = 0; jj < 4; ++jj) { if (4 * g + jj <= li) sc[0][jj] = -INFINITY; if (4 * g + jj > li) sc[8][jj] = -INFINITY; }
        if (n == 0) {
#pragma unroll
            for (int tt = 0; tt < 8; ++tt) if (sb + tt < 8) sc[tt] = (f32x4){-INFINITY, -INFINITY, -INFINITY, -INFINITY}; }
        float mx = sink2;
#pragma unroll
        for (int tt = 0; tt < 9; ++tt) mx = fmaxf(fmaxf(mx, fmaxf(sc[tt][0], sc[tt][1])), fmaxf(sc[tt][2], sc[tt][3]));
        mx = fmaxf(mx, __shfl_xor(mx, 16)); mx = fmaxf(mx, __shfl_xor(mx, 32));
        float l = 0.f;
#pragma unroll
        for (int tt = 0; tt < 9; ++tt)
#pragma unroll
            for (int jj = 0; jj < 4; ++jj) { const float p = fexp2(sc[tt][jj] - mx); sc[tt][jj] = p; l += p; }
        l += __shfl_xor(l, 16); l += __shfl_xor(l, 32); l += fexp2(sink2 - mx);
        const float inv = 1.0f / l;
        bf16x8 Pb[5];
#pragma unroll
        for (int k2 = 0; k2 < 4; ++k2) { u32x4 t; t.x = pkbf(sc[2 * k2][0], sc[2 * k2][1]); t.y = pkbf(sc[2 * k2][2], sc[2 * k2][3]); t.z = pkbf(sc[2 * k2 + 1][0], sc[2 * k2 + 1][1]); t.w = pkbf(sc[2 * k2 + 1][2], sc[2 * k2 + 1][3]); Pb[k2] = __builtin_bit_cast(bf16x8, t); }
        { u32x4 t; t.x = pkbf(sc[8][0], sc[8][1]); t.y = pkbf(sc[8][2], sc[8][3]); t.z = 0u; t.w = 0u; Pb[4] = __builtin_bit_cast(bf16x8, t); }
#pragma unroll
        for (int dt = 0; dt < 4; ++dt) { f32x4 o = (f32x4){0.f, 0.f, 0.f, 0.f};
#pragma unroll
            for (int k2 = 0; k2 < 4; ++k2) { LAS unsigned char* vp = Vb + (16 * (sb + 2 * k2) + 4 * g + q4) * 144 + (16 * dt + 4 * p4) * 2;
                o = mfma16(cat8(ldstr(vp), ldstr(vp + 16 * 144)), Pb[k2], o); }
            { LAS unsigned char* vp = Vb + (16 * (sb + 8) + 4 * g + q4) * 144 + (16 * dt + 4 * p4) * 2;
              o = mfma16(cat8(ldstr(vp), (s16x4){0, 0, 0, 0}), Pb[4], o); }
            u32x2 wv; wv.x = pkbf(o[0] * inv, o[1] * inv); wv.y = pkbf(o[2] * inv, o[3] * inv);
            *(u32x2*)(QA + tok * 1024 + head * 64 + 16 * dt + 4 * g) = wv; }
    }
    __syncthreads();
}

constexpr int RK_STRIDE = 528, RV_STRIDE = 144, R_KOFF = 0, R_VOFF = 128 * RK_STRIDE, R_SOFF = R_VOFF + 128 * RV_STRIDE;
__device__ __forceinline__ void ret_unit(LAS unsigned char* lds, const bf16_t* QR, const bf16_t* KR, bf16_t* VR, const bf16_t* GR, float* SS, int b, int h, int vs, int tid) {
    const int lane = tid & 63, w = __builtin_amdgcn_readfirstlane(tid >> 6), g = lane >> 4, li = lane & 15, q4 = li >> 2, p4 = li & 3;
    LAS unsigned char* Kl = lds + R_KOFF; LAS unsigned char* Vl = lds + R_VOFF; LAS unsigned char* Sl0 = lds + R_SOFF;
    const float lg = log2f(1.0f - exp2f(-5.0f - (float)h));
    const int rb = w < 4 ? w : 11 - w;
    const int irow = 16 * rb + li;
    const float rho = fexp2((float)(irow - 127) * lg), xi = fexp2((float)(irow + 1) * lg), g128 = fexp2(128.0f * lg);
    const float zeta0 = fexp2((float)(127 - (tid >> 3)) * lg), zeta1 = fexp2((float)(127 - 64 - (tid >> 3)) * lg);
    for (int id = tid; id < 64 * RK_STRIDE / 16; id += 512) *(LAS u32x4*)(Sl0 + id * 16) = (u32x4){0u, 0u, 0u, 0u};
    f32x4 S[2][4];
#pragma unroll
    for (int a = 0; a < 2; ++a)
#pragma unroll
        for (int v = 0; v < 4; ++v) S[a][v] = (f32x4){0.f, 0.f, 0.f, 0.f};
    u32x4 kreg[8], vreg[2]; u32x2 greg[4]; bf16x8 Qf[8], Qn[8];
    const unsigned koff = (unsigned)(((tid >> 5) * 1024 + (tid & 31) * 8) * 2), voff = (unsigned)(((tid >> 3) * 2048 + (tid & 7) * 8) * 2);
    const unsigned qoff = (unsigned)((irow * 1024 + 8 * g) * 2), goff = (unsigned)((irow * 2048 + 4 * g) * 2);
    const char* const kbase0 = (const char*)KR + ((size_t)b * SEQ * 1024 + h * 256) * 2; const char* const qbase0 = (const char*)QR + ((size_t)b * SEQ * 1024 + h * 256) * 2;
    char* const vbase0 = (char*)VR + ((size_t)b * SEQ * 2048 + h * 512 + vs * 64) * 2; const char* const gbase0 = (const char*)GR + ((size_t)b * SEQ * 2048 + h * 512 + vs * 64) * 2;
#define RET_LOAD_KV(cc) do { const char* kb_ = kbase0 + (size_t)(cc) * (128 * 1024 * 2); const char* vb_ = vbase0 + (size_t)(cc) * (128 * 2048 * 2); \
        _Pragma("unroll") for (int it = 0; it < 8; ++it) kreg[it] = *(const u32x4*)(kb_ + it * (16 * 1024 * 2) + koff); \
        _Pragma("unroll") for (int it = 0; it < 2; ++it) vreg[it] = *(const u32x4*)(vb_ + it * (64 * 2048 * 2) + voff); } while (0)
#define RET_LOAD_G(cc) do { const char* gb_ = gbase0 + (size_t)(cc) * (128 * 2048 * 2); \
        _Pragma("unroll") for (int vt = 0; vt < 4; ++vt) greg[vt] = *(const u32x2*)(gb_ + vt * 32 + goff); } while (0)
#define RET_LOAD_Q(cc) do { const char* qb_ = qbase0 + (size_t)(cc) * (128 * 1024 * 2); \
        _Pragma("unroll") for (int kk = 0; kk < 8; ++kk) Qn[kk] = *(const bf16x8*)(qb_ + kk * 64 + qoff); } while (0)
    RET_LOAD_KV(0); RET_LOAD_Q(0); RET_LOAD_G(0);
    for (int c = 0; c < 64; ++c) {
        const size_t tok0 = (size_t)b * SEQ + 128 * c;
        LAS unsigned char* Sl = Sl0 + (c & 1) * (64 * RK_STRIDE); LAS unsigned char* Sw = Sl0 + ((c + 1) & 1) * (64 * RK_STRIDE);
        __syncthreads();
#pragma unroll
        for (int it = 0; it < 8; ++it) { const int id = tid + 512 * it, row = id >> 5, part = id & 31; *(LAS u32x4*)(Kl + row * RK_STRIDE + part * 16) = kreg[it]; }
#pragma unroll
        for (int it = 0; it < 2; ++it) { const int id = tid + 512 * it, row = id >> 3, part = id & 7; const float z = it ? zeta1 : zeta0; const u32x4 v = vreg[it];
            u32x4 o; o.x = pkbf(bflo(v.x) * z, bfhi(v.x) * z); o.y = pkbf(bflo(v.y) * z, bfhi(v.y) * z); o.z = pkbf(bflo(v.z) * z, bfhi(v.z) * z); o.w = pkbf(bflo(v.w) * z, bfhi(v.w) * z);
            *(LAS u32x4*)(Vl + row * RV_STRIDE + part * 16) = o; }
#pragma unroll
        for (int kk = 0; kk < 8; ++kk) Qf[kk] = Qn[kk];
        __syncthreads();
        if (c + 1 < 64) RET_LOAD_KV(c + 1);
        f32x4 P[8];
#pragma unroll
        for (int t = 0; t < 8; ++t) { P[t] = (f32x4){0.f, 0.f, 0.f, 0.f};
            if (t <= rb) { LAS unsigned char* kp = Kl + (16 * t + li) * RK_STRIDE + 16 * g;
#pragma unroll
                for (int kk = 0; kk < 8; ++kk) P[t] = mfma16(ldsrow(kp + 64 * kk), Qf[kk], P[t]);
                if (t == rb) {
#pragma unroll
                    for (int jj = 0; jj < 4; ++jj) if (4 * g + jj > li) P[t][jj] = 0.f; } } }
        if (c + 1 < 64) RET_LOAD_Q(c + 1);
        bf16x8 Pb[4];
#pragma unroll
        for (int k2 = 0; k2 < 4; ++k2) { u32x4 t; t.x = pkbf(P[2 * k2][0], P[2 * k2][1]); t.y = pkbf(P[2 * k2][2], P[2 * k2][3]); t.z = pkbf(P[2 * k2 + 1][0], P[2 * k2 + 1][1]); t.w = pkbf(P[2 * k2 + 1][2], P[2 * k2 + 1][3]); Pb[k2] = __builtin_bit_cast(bf16x8, t); }
        float ssq = 0.f;
#pragma unroll
        for (int vt = 0; vt < 4; ++vt) { f32x4 a1 = (f32x4){0.f, 0.f, 0.f, 0.f}, a2 = (f32x4){0.f, 0.f, 0.f, 0.f};
#pragma unroll
            for (int k2 = 0; k2 < 4; ++k2) if (2 * k2 <= rb) { LAS unsigned char* vp = Vl + (32 * k2 + 4 * g + q4) * RV_STRIDE + (16 * vt + 4 * p4) * 2;
                a1 = mfma16(cat8(ldstr(vp), ldstr(vp + 16 * RV_STRIDE)), Pb[k2], a1); }
            LAS unsigned char* sp = Sl + (16 * vt + li) * RK_STRIDE + 16 * g;
#pragma unroll
            for (int kk = 0; kk < 8; ++kk) a2 = mfma16(ldsrow(sp + 64 * kk), Qf[kk], a2);
            const f32x4 o = a1 * rho + a2 * xi;
            ssq += (o[0] * o[0] + o[1] * o[1]) + (o[2] * o[2] + o[3] * o[3]);
            const u32x2 gq = greg[vt];
            u32x2 wv; wv.x = pkbf(o[0] * bflo(gq.x), o[1] * bfhi(gq.x)); wv.y = pkbf(o[2] * bflo(gq.y), o[3] * bfhi(gq.y));
            *(u32x2*)(vbase0 + (size_t)c * (128 * 2048 * 2) + vt * 32 + goff) = wv; }
        if (c + 1 < 64) RET_LOAD_G(c + 1);
        ssq += __shfl_xor(ssq, 16); ssq += __shfl_xor(ssq, 32);
        if (g == 0) atomicAdd(SS + (tok0 + irow) * 4 + h, ssq);
#pragma unroll
        for (int a = 0; a < 2; ++a)
#pragma unroll
            for (int v = 0; v < 4; ++v) S[a][v] = S[a][v] * g128;
#pragma unroll
        for (int kk = 0; kk < 4; ++kk) { bf16x8 Af[2], Bf[4];
#pragma unroll
            for (int a = 0; a < 2; ++a) { LAS unsigned char* kp = Kl + (32 * kk + 8 * g + q4) * RK_STRIDE + (16 * (2 * w + a) + 4 * p4) * 2; Af[a] = cat8(ldstr(kp), ldstr(kp + 4 * RK_STRIDE)); }
#pragma unroll
            for (int v = 0; v < 4; ++v) { LAS unsigned char* vp = Vl + (32 * kk + 8 * g + q4) * RV_STRIDE + (16 * v + 4 * p4) * 2; Bf[v] = cat8(ldstr(vp), ldstr(vp + 4 * RV_STRIDE)); }
#pragma unroll
            for (int a = 0; a < 2; ++a)
#pragma unroll
                for (int v = 0; v < 4; ++v) S[a][v] = mfma16(Af[a], Bf[v], S[a][v]); }
#pragma unroll
        for (int a = 0; a < 2; ++a)
#pragma unroll
            for (int v = 0; v < 4; ++v) { u32x2 wv; wv.x = pkbf(S[a][v][0], S[a][v][1]); wv.y = pkbf(S[a][v][2], S[a][v][3]);
                *(LAS u32x2*)(Sw + (16 * v + li) * RK_STRIDE + (16 * (2 * w + a) + 4 * g) * 2) = wv; }
    }
    __syncthreads();
}

constexpr int BAR_STRIDE = 64;
__device__ __forceinline__ void grid_bar(unsigned* bar, unsigned k, unsigned G) {
    asm volatile("s_waitcnt vmcnt(0)" ::: "memory");
    __syncthreads();
    if (threadIdx.x == 0) {
        const unsigned grp = blockIdx.x & 7u, ngrp = G < 8u ? G : 8u, nloc = (G - grp + 7u) >> 3;
        unsigned* gcnt = bar + grp * BAR_STRIDE; unsigned* gflag = bar + (8 + grp) * BAR_STRIDE; unsigned* top = bar + 16 * BAR_STRIDE;
        __builtin_amdgcn_fence(__ATOMIC_RELEASE, "agent");
        asm volatile("s_waitcnt vmcnt(0)" ::: "memory");
        const unsigned old = __hip_atomic_fetch_add(gcnt, 1u, __ATOMIC_RELAXED, __HIP_MEMORY_SCOPE_AGENT);
        if (old + 1u == k * nloc) {
            __hip_atomic_fetch_add(top, 1u, __ATOMIC_RELAXED, __HIP_MEMORY_SCOPE_AGENT);
            while (__hip_atomic_load(top, __ATOMIC_RELAXED, __HIP_MEMORY_SCOPE_AGENT) < k * ngrp) __builtin_amdgcn_s_sleep(1);
            __hip_atomic_store(gflag, k, __ATOMIC_RELAXED, __HIP_MEMORY_SCOPE_AGENT);
        } else {
            while (__hip_atomic_load(gflag, __ATOMIC_RELAXED, __HIP_MEMORY_SCOPE_AGENT) < k) __builtin_amdgcn_s_sleep(1);
        }
        __builtin_amdgcn_fence(__ATOMIC_ACQUIRE, "agent");
        asm volatile("s_waitcnt vmcnt(0)" ::: "memory");
    }
    __syncthreads();
}
struct Args { const float* in[13]; float* out; unsigned char* ws; int ph_lo, ph_hi, coop, pad; };

__global__ void __launch_bounds__(512, 2) fwd_kernel(Args a) {
    extern __shared__ __attribute__((aligned(16))) unsigned char lds_raw[];
    LAS unsigned char* lds = (LAS unsigned char*)lds_raw;
    cg::grid_group grid = cg::this_grid();
    const int tid = threadIdx.x, lane = tid & 63, wave = __builtin_amdgcn_readfirstlane(tid >> 6);
    const int G = gridDim.x, bid = blockIdx.x;
    const int gw = bid * 8 + wave, NGW = G * 8;
    unsigned char* ws = a.ws;
    const float* x = a.in[0];
    bf16_t* QA = (bf16_t*)(ws + WS_QA); bf16_t* KVA = (bf16_t*)(ws + WS_KVA); bf16_t* QR = (bf16_t*)(ws + WS_QR); bf16_t* KR = (bf16_t*)(ws + WS_KR);
    bf16_t* VR = (bf16_t*)(ws + WS_VR); bf16_t* GR = (bf16_t*)(ws + WS_GR);
    bf16_t* WIN = (bf16_t*)(ws + WS_WIN); bf16_t* WBA = (bf16_t*)(ws + WS_WBA); bf16_t* WBR = (bf16_t*)(ws + WS_WBR); bf16_t* WOUT = (bf16_t*)(ws + WS_WOUT);
    bf16_t* WGU = (bf16_t*)(ws + WS_WGU); bf16_t* WD = (bf16_t*)(ws + WS_WD);
    float* SS = (float*)(ws + WS_SS); float* SS2 = (float*)(ws + WS_SS2);
    unsigned char* SZ = (unsigned char*)(ws + WS_SZ); bf16_t* X1 = (bf16_t*)(ws + WS_X1); bf16_t* XN2 = (bf16_t*)(ws + WS_XN2); bf16_t* H = (bf16_t*)(ws + WS_H);
    bf16_t* XN = (bf16_t*)((unsigned char*)a.out + OUT_XN); bf16_t* BA = (bf16_t*)((unsigned char*)a.out + OUT_BA);
    const int lo = a.ph_lo, hi = a.ph_hi;
#define IN(k) (lo <= (k) && (k) < hi)
#ifdef PROBE_DELAY
    unsigned long long tmark = __builtin_amdgcn_s_memrealtime();
#define STAMP(i) do { if ((PROBE_DELAY >> (i)) & 1) { const unsigned long long tb_ = __builtin_amdgcn_s_memrealtime(), d_ = tb_ - tmark; \
        while (__builtin_amdgcn_s_memrealtime() - tb_ < d_) __builtin_amdgcn_s_sleep(8); } tmark = __builtin_amdgcn_s_memrealtime(); } while (0)
#else
#define STAMP(i) do { } while (0)
#endif
    unsigned* const barcnt = (unsigned*)(ws + WS_END);
#define SEAM(k) do { if (a.coop && IN(k) && IN((k) + 1)) { if ((k) == 0) grid.sync(); else grid_bar(barcnt, (unsigned)(k), (unsigned)G); } } while (0)

    if (IN(0)) {
        LAS float* scr = (LAS float*)(lds + wave * 16384);
        constexpr int I_IN = 16 * (DIN / 32), I_BA = 16 * 32, I_BR = 32 * 32, I_OUT = 16 * 32, I_G = 16 * (DFF / 32), I_D = (DFF / 64) * 32;
        constexpr int NITEMS = I_IN + I_BA + I_BR + I_OUT + 2 * I_G + I_D;
        for (int it = gw; it < NITEMS; it += NGW) {
            int r = it;
            if (r < I_IN) { const int nb = DIN / 32, kb = r / nb, n0 = 32 * (r % nb); transpose_item(a.in[2], DIN, WIN, 1024, 64 * kb, n0, n0, scr, lane); continue; } r -= I_IN;
            if (r < I_BA) { const int kb = r / 32, n0 = 32 * (r % 32); transpose_item(a.in[6], 1024, WBA, 1024, 64 * kb, n0, n0, scr, lane); continue; } r -= I_BA;
            if (r < I_BR) { const int kb = r / 32, n0 = 32 * (r % 32); transpose_item(a.in[7], 1024, WBR, 2048, 64 * kb, n0, n0, scr, lane); continue; } r -= I_BR;
            if (r < I_OUT) { const int kb = r / 32, n0 = 32 * (r % 32); transpose_item(a.in[8], 1024, WOUT, 1024, 64 * kb, n0, n0, scr, lane); continue; } r -= I_OUT;
            if (r < I_G) { const int nb = DFF / 32, kb = r / nb, n0 = 32 * (r % nb); transpose_item(a.in[10], DFF, WGU, 1024, 64 * kb, n0, 256 * (n0 >> 7) + (n0 & 127), scr, lane); continue; } r -= I_G;
            if (r < I_G) { const int nb = DFF / 32, kb = r / nb, n0 = 32 * (r % nb); transpose_item(a.in[11], DFF, WGU, 1024, 64 * kb, n0, 256 * (n0 >> 7) + 128 + (n0 & 127), scr, lane); continue; } r -= I_G;
            { const int kb = r / 32, n0 = 32 * (r % 32); transpose_item(a.in[12], 1024, WD, DFF, 64 * kb, n0, n0, scr, lane); }
        }
        const float* g1 = a.in[1];
        f32x4 gv[4];
#pragma unroll
        for (int j = 0; j < 4; ++j) gv[j] = *(const f32x4*)(g1 + 4 * lane + 256 * j);
        f32x4 vn[4];
        { const f32x4* xr = (const f32x4*)(x + (size_t)gw * DM) + lane;
#pragma unroll
          for (int j = 0; j < 4; ++j) vn[j] = xr[64 * j]; }
        for (int m = gw; m < M_TOK; m += NGW) {
            f32x4 v[4]; float s = 0.f;
#pragma unroll
            for (int j = 0; j < 4; ++j) v[j] = vn[j];
            if (m + NGW < M_TOK) { const f32x4* xr = (const f32x4*)(x + (size_t)(m + NGW) * DM) + lane;
#pragma unroll
                for (int j = 0; j < 4; ++j) vn[j] = xr[64 * j]; }
#pragma unroll
            for (int j = 0; j < 4; ++j) s += (v[j][0] * v[j][0] + v[j][1] * v[j][1]) + (v[j][2] * v[j][2] + v[j][3] * v[j][3]);
            const float rstd = 1.0f / sqrtf(wave_sum(s) * (1.0f / DM) + EPS);
            u32x2* o8 = (u32x2*)(XN + (size_t)m * DM) + lane;
#pragma unroll
            for (int j = 0; j < 4; ++j) { const f32x4 t = v[j] * rstd * gv[j]; u32x2 wv; wv.x = pkbf(t[0], t[1]); wv.y = pkbf(t[2], t[3]); o8[64 * j] = wv; }
        }
        for (int i = bid * 512 + tid; i < M_TOK * 4 / 4; i += G * 512) ((f32x4*)SS)[i] = (f32x4){0.f, 0.f, 0.f, 0.f};
        for (int i = bid * 512 + tid; i < M_TOK / 4; i += G * 512) ((f32x4*)SS2)[i] = (f32x4){0.f, 0.f, 0.f, 0.f};
        if (bid == 0 && tid < 17) __hip_atomic_store(barcnt + tid * BAR_STRIDE, 0u, __ATOMIC_RELAXED, __HIP_MEMORY_SCOPE_AGENT);
        __syncthreads();
    }
    SEAM(0); STAMP(1);
    if (IN(1)) {
        pg8::Gemm g{XN, WIN, 1024, 1024, M_TOK, N_IN1, 1024}; pg8::StaticOrder S; S.init(M_TOK, N_IN1, G, bid);
        EpiIn E{QA, KVA, QR, KR, VR, GR};
        pg8::gemm_phase(lds, g, S, E);
    }
    SEAM(1); STAMP(2);
    if (IN(2)) {
        for (int u = bid; u < 256; u += G) { const int xcd = u & 7, idx = u >> 3, bh = xcd * 4 + (idx >> 3), vs = idx & 7; ret_unit(lds, QR, KR, VR, GR, SS, bh >> 2, bh & 3, vs, tid); }
        STAMP(9);
        { u32x4 kvr[4], vvr[4];
          if (bid < 1024) attn_load(KVA, bid >> 7, (bid >> 1) & 63, bid & 1, tid, kvr, vvr);
          for (int u = bid; u < 1024; u += G) attn_unit(lds, QA, KVA, a.in[3], a.in[4], a.in[5], u >> 7, (u >> 1) & 63, u & 1, tid, kvr, vvr, u + G); }
    }
    SEAM(2); STAMP(3);
    if (IN(3)) {
        { pg8::Gemm g{XN, WIN + (size_t)N_IN1 * 1024, 1024, 1024, M_TOK, 2048, 1024}; pg8::StaticOrder S; S.init(M_TOK, 2048, G, bid); EpiSig8 E{SZ}; pg8::gemm_phase(lds, g, S, E); }
        { pg8::Gemm g{QA, WBA, 1024, 1024, M_TOK, 1024, 1024}; pg8::StaticOrder S; S.init(M_TOK, 1024, G, bid); EpiBf<0> E{BA, 1024}; pg8::gemm_phase(lds, g, S, E); }
    }
    SEAM(3); STAMP(4);
    if (IN(4)) {
        pg8::Gemm g{VR, WBR, 2048, 2048, M_TOK, 1024, 2048}; pg8::StaticOrder S; S.init(M_TOK, 1024, G, bid, 1); EpiMerge E{SZ, BA}; pg8::gemm_phase<EpiMerge, pg8::StaticOrder, true>(lds, g, S, E, SS);
    }
    SEAM(4); STAMP(5);
    if (IN(5)) {
        pg8::Gemm g{BA, WOUT, 1024, 1024, M_TOK, 1024, 1024}; pg8::StaticOrder S; S.init(M_TOK, 1024, G, bid); EpiOut E{x, a.in[9], X1, XN2, SS2}; pg8::gemm_phase(lds, g, S, E);
    }
    SEAM(5); STAMP(6);
    if (IN(6)) {
        pg8::Gemm g{XN2, WGU, 1024, 1024, M_TOK, 2 * DFF, 1024}; pg8::StaticOrder S; S.init(M_TOK, 2 * DFF, G, bid, 1); EpiGU E{(LAS const float*)(lds + pg8::STAGE_BYTES), H}; pg8::gemm_phase<EpiGU, pg8::StaticOrder, false, true>(lds, g, S, E, SS2);
    }
    SEAM(6); STAMP(7);
    if (IN(7)) {
        pg8::Gemm g{H, WD, DFF, DFF, M_TOK, 1024, DFF}; pg8::StaticOrder S; S.init(M_TOK, 1024, G, bid); EpiDown E{X1, a.out}; pg8::gemm_phase(lds, g, S, E);
    }
    STAMP(8);
#undef IN
#undef SEAM
}

#ifndef MK_COOP
#define MK_COOP 1
#endif
extern "C" void kernel_launch(void* const* d_in, const int* in_sizes, int n_in, void* d_out, int out_size, void* d_ws, size_t ws_size, hipStream_t stream) {
    static int grid = 0;
    if (grid == 0) {
        if (n_in != 13 || in_sizes[0] != M_TOK * DM || out_size != M_TOK * DM || ws_size < WS_END) { fprintf(stderr, "kernel_launch: unexpected shapes (n_in %d, in0 %d, out %d, ws %zu)\n", n_in, n_in > 0 ? in_sizes[0] : -1, out_size, ws_size); grid = -1; return; }
        int dev = 0, cus = 0, per_cu = 0;
        hipGetDevice(&dev); hipDeviceGetAttribute(&cus, hipDeviceAttributeMultiprocessorCount, dev);
        if (hipFuncSetAttribute((const void*)fwd_kernel, hipFuncAttributeMaxDynamicSharedMemorySize, LDS_BYTES) != hipSuccess) { fprintf(stderr, "kernel_launch: hipFuncSetAttribute failed\n"); grid = -1; return; }
        if (hipOccupancyMaxActiveBlocksPerMultiprocessor(&per_cu, (const void*)fwd_kernel, 512, LDS_BYTES) != hipSuccess || per_cu < 1) { fprintf(stderr, "kernel_launch: occupancy query says %d\n", per_cu); per_cu = 1; }
        (void)hipGetLastError();
        grid = cus * per_cu; if (grid > 256) grid = 256;
        fprintf(stderr, "kernel_launch: grid %d (cus %d, per_cu %d)\n", grid, cus, per_cu);
    }
    if (grid < 0) return;
    Args a{};
    for (int i = 0; i < 13; ++i) a.in[i] = (const float*)d_in[i];
    a.out = (float*)d_out; a.ws = (unsigned char*)d_ws;
#if MK_COOP
    a.ph_lo = 0; a.ph_hi = 8; a.coop = 1; a.pad = 0;
    void* args[] = {&a};
    hipError_t e = hipLaunchCooperativeKernel((const void*)fwd_kernel, dim3(grid), dim3(512), args, LDS_BYTES, stream);
    if (e != hipSuccess) fprintf(stderr, "cooperative launch failed: %s (grid %d)\n", hipGetErrorString(e), grid);
#else
    for (int p = 0; p < 8; ++p) { a.ph_lo = p; a.ph_hi = p + 1; a.coop = 0; a.pad = 0; hipLaunchKernelGGL(fwd_kernel, dim3(grid), dim3(512), LDS_BYTES, stream, a); }
#endif
}
```

```cpp
#include <hip/hip_runtime.h>
#include <hip/hip_cooperative_groups.h>
#include <cstdio>
#include <cstdint>
namespace cg = cooperative_groups;

#define LAS __attribute__((address_space(3)))
typedef unsigned short bf16_t;
typedef short bf16x8 __attribute__((ext_vector_type(8)));
typedef short s16x4 __attribute__((ext_vector_type(4)));
typedef float f32x4 __attribute__((ext_vector_type(4)));
typedef float f32x2 __attribute__((ext_vector_type(2)));
typedef unsigned u32x4 __attribute__((ext_vector_type(4)));
typedef unsigned u32x2 __attribute__((ext_vector_type(2)));
typedef __bf16 bf16x2_t __attribute__((ext_vector_type(2)));

constexpr int M_TOK = 65536, SEQ = 8192, DM = 1024, DIN = 9472, DFF = 2816;
constexpr int N_IN1 = 7424;
constexpr float EPS = 1e-6f;
constexpr float LOG2E = 1.4426950408889634f;

constexpr size_t MiB = 1u << 20;
constexpr size_t WS_QA = 0, WS_KVA = 128 * MiB, WS_QR = 160 * MiB, WS_KR = 288 * MiB, WS_VR = 416 * MiB, WS_GR = 672 * MiB;
constexpr size_t WS_WIN = 928 * MiB, WS_WBA = 947 * MiB, WS_WBR = 949 * MiB, WS_WOUT = 953 * MiB, WS_WGU = 955 * MiB, WS_WD = 966 * MiB;
constexpr size_t WS_SS = 972 * MiB, WS_SS2 = 973 * MiB, WS_END = 974 * MiB;
constexpr size_t WS_SZ = WS_QR, WS_X1 = WS_GR, WS_XN2 = WS_QA, WS_H = WS_QR;
constexpr size_t OUT_XN = 0, OUT_BA = 128 * MiB;

constexpr int LDS_BYTES = 155648;

__device__ __forceinline__ unsigned pkbf(float lo, float hi) { f32x2 v = {lo, hi}; bf16x2_t b = __builtin_convertvector(v, bf16x2_t); return __builtin_bit_cast(unsigned, b); }
__device__ __forceinline__ float bflo(unsigned u) { return __uint_as_float(u << 16); }
__device__ __forceinline__ float bfhi(unsigned u) { return __uint_as_float(u & 0xffff0000u); }
__device__ __forceinline__ float fexp2(float x) { return __builtin_amdgcn_exp2f(x); }
__device__ __forceinline__ float frcp(float x) { return __builtin_amdgcn_rcpf(x); }
__device__ __forceinline__ float sigmoidf_(float x) { return frcp(1.f + fexp2(-x * LOG2E)); }
__device__ __forceinline__ float siluf_(float x) { return x * sigmoidf_(x); }
__device__ __forceinline__ float wave_sum(float v) {
#pragma unroll
    for (int o = 1; o < 64; o <<= 1) v += __shfl_xor(v, o);
    return v;
}
__device__ __forceinline__ f32x4 mfma16(bf16x8 a, bf16x8 b, f32x4 c) { return __builtin_amdgcn_mfma_f32_16x16x32_bf16(a, b, c, 0, 0, 0); }
__device__ __forceinline__ s16x4 ldstr(LAS unsigned char* p) { return __builtin_bit_cast(s16x4, __builtin_amdgcn_ds_read_tr16_b64_v4i16((LAS s16x4*)p)); }
__device__ __forceinline__ bf16x8 cat8(s16x4 lo, s16x4 hi) { return (bf16x8){lo[0], lo[1], lo[2], lo[3], hi[0], hi[1], hi[2], hi[3]}; }
__device__ __forceinline__ bf16x8 ldsrow(LAS unsigned char* p) { return *(LAS bf16x8*)p; }

#ifndef PG8_USE_SP2
#define PG8_USE_SP2 1
#endif
namespace pg8 {
constexpr int BM = 256, BK = 64, HALF = 128, HTB = HALF * BK * 2, STAGE_BYTES = 8 * HTB, NXCD = 8, WGM = 4;
__device__ __forceinline__ int lds_byte(int r, int c) { const int st = (r >> 4) * 2 + (c >> 5), rr = r & 15, cc = c & 31, ob = rr * 64 + cc * 2; return st * 1024 + (ob ^ (((ob >> 9) & 1) << 5)); }
__device__ __forceinline__ void stage_rc(int b, int& R, int& C) { const int st = b / 1024, sb = b % 1024, swz = sb ^ (((sb >> 9) & 1) << 5); R = (st >> 1) * 16 + swz / 64; C = (st & 1) * 32 + (swz % 64) / 2; }
__device__ __forceinline__ int perm32(int rho) { const int n = rho >> 4, i = rho & 15; return 8 * (i >> 2) + 4 * n + (i & 3); }

struct Unit { int pm, pn; };
struct Gemm { const bf16_t* A; const bf16_t* Bt; int lda, ldb, M, N, K; };

struct StaticOrder {
    int nM, nN, nwg, G, c, rev;
    __device__ void init(int M, int N, int G_, int c_, int rev_ = 0) { nM = M / BM; nN = N / BM; nwg = nM * nN; G = G_; c = c_; rev = rev_; }
    __device__ bool next(int i, Unit& u) const {
        const long L = (long)i * G + c; if (L >= nwg) return false;
        int wgid = (int)L; { const int q = nwg / NXCD, r = nwg % NXCD, xcd = wgid % NXCD, off = wgid / NXCD; wgid = (xcd < r ? xcd * (q + 1) : r * (q + 1) + (xcd - r) * q) + off; }
        const int nig = WGM * nN, gid = wgid / nig, fm = gid * WGM, gsz = (nM - fm) < WGM ? (nM - fm) : WGM;
        u.pm = fm + ((wgid % nig) % gsz); u.pn = (wgid % nig) / gsz; if (rev) u.pm = nM - 1 - u.pm; return true;
    }
};

template <class Epi, class Sched, bool HOOK = false, bool RSTD = false>
__device__ __forceinline__ void gemm_phase(LAS unsigned char* lds, const Gemm g, const Sched& S, const Epi& E, const float* hookSS = nullptr) {
    const int tid = threadIdx.x, wid = __builtin_amdgcn_readfirstlane(tid >> 6), lane = tid & 63, wr = wid >> 2, wc = wid & 3, fr = lane & 15, fq = lane >> 4;
    const int K = g.K, nt = K / BK;
    unsigned voffA[2], voffB[2];
#pragma unroll
    for (int i = 0; i < 2; ++i) { int R, C; stage_rc(tid * 16 + i * 8192, R, C); const int Rb = (R & ~31) + perm32(R & 31);
        voffA[i] = (unsigned)(R * g.lda + C) * 2u; voffB[i] = (unsigned)(Rb * g.ldb + C) * 2u; }
    const size_t kstep = (size_t)(BK * 2);
    const size_t hstepA = (size_t)HALF * g.lda * 2, hstepB = (size_t)HALF * g.ldb * 2;
    const size_t tstepA = 2 * hstepA, tstepB = 2 * hstepB;
    const unsigned ldsw = (unsigned)wid * 1024u;
    const int aoff = lds_byte(wr * 64 + fr, fq * 8), boff = lds_byte(wc * 32 + fr, fq * 8);
#define PG8_SA(b, h) (((b) * 2 + (h)) * HTB)
#define PG8_SB(b, h) ((4 + (b) * 2 + (h)) * HTB)
#define PG8_STAGE(bufoff, gbase, voff) do { _Pragma("unroll") for (int _i = 0; _i < 2; ++_i) \
        __builtin_amdgcn_global_load_lds((const unsigned*)((const char*)(gbase) + (voff)[_i]), (LAS unsigned*)(lds + (bufoff) + ldsw + _i * 8192), 16, 0, 0); } while (0)
#define PG8_LDA(dst, b, h) do { _Pragma("unroll") for (int m = 0; m < 4; ++m) _Pragma("unroll") for (int k = 0; k < 2; ++k) dst[m][k] = *(const LAS bf16x8*)(lds + PG8_SA(b, h) + aoff + m * 2048 + k * 1024); } while (0)
#define PG8_LDB(dst, b, h) do { _Pragma("unroll") for (int n = 0; n < 2; ++n) _Pragma("unroll") for (int k = 0; k < 2; ++k) dst[n][k] = *(const LAS bf16x8*)(lds + PG8_SB(b, h) + boff + n * 2048 + k * 1024); } while (0)
#define PG8_MMA(ai, bj, At, Bt) do { __builtin_amdgcn_s_setprio(1); _Pragma("unroll") for (int m = 0; m < 4; ++m) _Pragma("unroll") for (int n = 0; n < 2; ++n) _Pragma("unroll") for (int k = 0; k < 2; ++k) \
        acc[ai][bj][m][n] = __builtin_amdgcn_mfma_f32_16x16x32_bf16(Bt[n][k], At[m][k], acc[ai][bj][m][n], 0, 0, 0); __builtin_amdgcn_s_setprio(0); } while (0)
#define PG8_WAIT_V(n) asm volatile("s_waitcnt vmcnt(" #n ")" ::: "memory")
#define PG8_WAIT_L(n) asm volatile("s_waitcnt lgkmcnt(" #n ")" ::: "memory")
#define PG8_BAR __builtin_amdgcn_s_barrier()
#define PG8_SCHED __builtin_amdgcn_sched_barrier(0)
#define PG8_HOOK(idx) do { const LAS float* tab = (const LAS float*)(lds + STAGE_BYTES) + (idx) * 256 + wr * 64 + fr; \
                _Pragma("unroll") for (int ai = 0; ai < 2; ++ai) _Pragma("unroll") for (int m = 0; m < 4; ++m) { const float f = tab[ai * 128 + m * 16]; \
                    _Pragma("unroll") for (int bj = 0; bj < 2; ++bj) _Pragma("unroll") for (int n = 0; n < 2; ++n) acc[ai][bj][m][n] = acc[ai][bj][m][n] * f; \
                    asm volatile("" ::: "memory"); } } while (0)
    Unit cur, nxt; int ui = 0;
    if (!S.next(0, cur)) return;
    f32x4 acc[2][2][4][2];
#pragma unroll
    for (int a = 0; a < 2; ++a)
#pragma unroll
        for (int b = 0; b < 2; ++b)
#pragma unroll
            for (int m = 0; m < 4; ++m)
#pragma unroll
                for (int n = 0; n < 2; ++n) acc[a][b][m][n] = (f32x4){0.f, 0.f, 0.f, 0.f};
    bf16x8 At[4][2], B0[2][2], B1[2][2];
    const char* cA = (const char*)g.A + (size_t)cur.pm * tstepA; const char* cB = (const char*)g.Bt + (size_t)cur.pn * tstepB;
#if PG8_USE_SP2
    PG8_STAGE(PG8_SB(0, 0), cB, voffB); PG8_STAGE(PG8_SB(0, 1), cB + hstepB, voffB); PG8_STAGE(PG8_SA(0, 0), cA, voffA); PG8_STAGE(PG8_SA(0, 1), cA + hstepA, voffA);
    if (wr == 1) PG8_BAR;
    PG8_WAIT_V(2); PG8_BAR;
    PG8_STAGE(PG8_SB(1, 0), cB + kstep, voffB); PG8_STAGE(PG8_SA(1, 0), cA + kstep, voffA); PG8_STAGE(PG8_SB(1, 1), cB + hstepB + kstep, voffB);
    PG8_WAIT_V(6); PG8_BAR;
#else
    PG8_STAGE(PG8_SB(0, 0), cB, voffB); PG8_STAGE(PG8_SA(0, 0), cA, voffA); PG8_STAGE(PG8_SB(0, 1), cB + hstepB, voffB); PG8_STAGE(PG8_SA(0, 1), cA + hstepA, voffA);
    if (wr == 1) PG8_BAR;
    PG8_WAIT_V(4); PG8_BAR;
    PG8_STAGE(PG8_SB(1, 0), cB + kstep, voffB); PG8_STAGE(PG8_SA(1, 0), cA + kstep, voffA); PG8_STAGE(PG8_SB(1, 1), cB + hstepB + kstep, voffB);
    PG8_WAIT_V(6); PG8_BAR;
#endif
    for (;;) {
        if constexpr (HOOK) { if (tid >= 256) {
                const int tr_ = tid - 256;
                const f32x4 sv = *(const f32x4*)(hookSS + ((size_t)cur.pm * 256 + tr_) * 4);
                const float m0 = sv[0] * (1.0f / 512.0f) + EPS, m1 = sv[1] * (1.0f / 512.0f) + EPS, m2 = sv[2] * (1.0f / 512.0f) + EPS, m3 = sv[3] * (1.0f / 512.0f) + EPS;
                LAS float* tab = (LAS float*)(lds + STAGE_BYTES);
                tab[tr_] = sqrtf(m1 / m0); tab[256 + tr_] = sqrtf(m2 / m1); tab[512 + tr_] = sqrtf(m3 / m2); tab[768 + tr_] = 1.0f / sqrtf(m3); } }
        if constexpr (RSTD) { if (tid >= 256) {
                const int tr_ = tid - 256; LAS float* tab = (LAS float*)(lds + STAGE_BYTES);
                tab[tr_] = 1.0f / sqrtf(hookSS[(size_t)cur.pm * 256 + tr_] * (1.0f / 1024.0f) + EPS); } }
        const bool has_next = S.next(ui + 1, nxt);
        const char* nA = has_next ? (const char*)g.A + (size_t)nxt.pm * tstepA : cA; const char* nB = has_next ? (const char*)g.Bt + (size_t)nxt.pn * tstepB : cB;
        for (int ts = 0; ts < nt; ts += (HOOK ? 8 : nt)) {
        const int te = HOOK ? ts + 8 : nt;
        if constexpr (HOOK) { if (ts != 0) PG8_HOOK((ts >> 3) - 1); }
        for (int t = ts; t < te; t += 2) {
            const bool last = (t == nt - 2);
            const char* a1 = cA + (size_t)(t + 1) * kstep;
            const char* a2 = last ? nA : cA + (size_t)(t + 2) * kstep; const char* b2 = last ? nB : cB + (size_t)(t + 2) * kstep;
            const char* a3 = a2 + kstep; const char* b3 = b2 + kstep;
#if PG8_USE_SP2
            PG8_LDB(B0, 0, 0); PG8_LDB(B1, 0, 1); PG8_SCHED; PG8_LDA(At, 0, 0); PG8_STAGE(PG8_SA(1, 1), a1 + hstepA, voffA);
            PG8_WAIT_V(8); PG8_WAIT_L(0); PG8_BAR; PG8_MMA(0, 0, At, B0); PG8_MMA(0, 1, At, B1); PG8_BAR; PG8_SCHED;
            PG8_LDA(At, 0, 1); PG8_STAGE(PG8_SB(0, 0), b2, voffB); PG8_STAGE(PG8_SB(0, 1), b2 + hstepB, voffB); PG8_STAGE(PG8_SA(0, 0), a2, voffA);
            PG8_WAIT_V(8); PG8_WAIT_L(0); PG8_BAR; PG8_MMA(1, 0, At, B0); PG8_MMA(1, 1, At, B1); PG8_BAR; PG8_SCHED;
            PG8_LDB(B0, 1, 0); PG8_LDB(B1, 1, 1); PG8_SCHED; PG8_LDA(At, 1, 0); PG8_STAGE(PG8_SA(0, 1), a2 + hstepA, voffA);
            PG8_WAIT_V(8); PG8_WAIT_L(0); PG8_BAR; PG8_MMA(0, 0, At, B0); PG8_MMA(0, 1, At, B1); PG8_BAR; PG8_SCHED;
            PG8_LDA(At, 1, 1); PG8_STAGE(PG8_SB(1, 0), b3, voffB); PG8_STAGE(PG8_SB(1, 1), b3 + hstepB, voffB); PG8_STAGE(PG8_SA(1, 0), a3, voffA);
            PG8_WAIT_V(8); PG8_WAIT_L(0); PG8_BAR; PG8_MMA(1, 0, At, B0); PG8_MMA(1, 1, At, B1); PG8_BAR; PG8_SCHED;
#else
            PG8_LDB(B0, 0, 0); PG8_SCHED; PG8_LDA(At, 0, 0); PG8_STAGE(PG8_SA(1, 1), a1 + hstepA, voffA);
            PG8_WAIT_L(8); PG8_BAR; PG8_WAIT_L(0); PG8_MMA(0, 0, At, B0); PG8_BAR; PG8_SCHED;
            PG8_LDB(B1, 0, 1); PG8_STAGE(PG8_SB(0, 0), b2, voffB);
            PG8_BAR; PG8_WAIT_L(0); PG8_MMA(0, 1, At, B1); PG8_BAR;
            PG8_LDA(At, 0, 1); PG8_STAGE(PG8_SA(0, 0), a2, voffA);
            PG8_BAR; PG8_WAIT_L(0); PG8_MMA(1, 0, At, B0); PG8_BAR; PG8_SCHED;
            PG8_STAGE(PG8_SB(0, 1), b2 + hstepB, voffB);
            PG8_WAIT_V(6); PG8_BAR; PG8_MMA(1, 1, At, B1); PG8_BAR;
            PG8_LDB(B0, 1, 0); PG8_SCHED; PG8_LDA(At, 1, 0); PG8_STAGE(PG8_SA(0, 1), a2 + hstepA, voffA);
            PG8_WAIT_L(8); PG8_BAR; PG8_WAIT_L(0); PG8_MMA(0, 0, At, B0); PG8_BAR; PG8_SCHED;
            PG8_LDB(B1, 1, 1); PG8_STAGE(PG8_SB(1, 0), b3, voffB);
            PG8_BAR; PG8_WAIT_L(0); PG8_MMA(0, 1, At, B1); PG8_BAR;
            PG8_LDA(At, 1, 1); PG8_STAGE(PG8_SA(1, 0), a3, voffA);
            PG8_BAR; PG8_WAIT_L(0); PG8_MMA(1, 0, At, B0); PG8_BAR; PG8_SCHED;
            PG8_STAGE(PG8_SB(1, 1), b3 + hstepB, voffB);
            PG8_WAIT_V(6); PG8_BAR; PG8_MMA(1, 1, At, B1); PG8_BAR;
#endif
        }
        }
        if (wr == 0) PG8_BAR;
        if constexpr (HOOK) PG8_HOOK(3);
        E(acc, cur, wr, wc, fr, fq);
        if (!has_next) break;
#pragma unroll
        for (int a = 0; a < 2; ++a)
#pragma unroll
            for (int b = 0; b < 2; ++b)
#pragma unroll
                for (int m = 0; m < 4; ++m)
#pragma unroll
                    for (int n = 0; n < 2; ++n) acc[a][b][m][n] = (f32x4){0.f, 0.f, 0.f, 0.f};
        cur = nxt; cA = nA; cB = nB; ++ui;
        if (wr == 1) PG8_BAR;
    }
    PG8_WAIT_V(0);
    PG8_BAR;
#undef PG8_SA
#undef PG8_SB
#undef PG8_STAGE
#undef PG8_LDA
#undef PG8_LDB
#undef PG8_MMA
#undef PG8_WAIT_V
#undef PG8_WAIT_L
#undef PG8_BAR
#undef PG8_SCHED
#undef PG8_HOOK
}
}
using pg8::Unit;
typedef const f32x4 (&AccRef)[2][2][4][2];

__device__ __forceinline__ void st8bf(bf16_t* p, const float* o) { u32x4 w; w.x = pkbf(o[0], o[1]); w.y = pkbf(o[2], o[3]); w.z = pkbf(o[4], o[5]); w.w = pkbf(o[6], o[7]); *(u32x4*)p = w; }
__device__ __forceinline__ void ld8bf(const bf16_t* p, float* o) { const u32x4 w = *(const u32x4*)p; o[0] = bflo(w.x); o[1] = bfhi(w.x); o[2] = bflo(w.y); o[3] = bfhi(w.y); o[4] = bflo(w.z); o[5] = bfhi(w.z); o[6] = bflo(w.w); o[7] = bfhi(w.w); }

struct EpiIn {
    bf16_t *QA, *KVA, *QR, *KR, *VR, *GR;
    __device__ __forceinline__ void operator()(AccRef acc, const Unit& u, int wr, int wc, int fr, int fq) const {
        const int pn = u.pn; bf16_t* base; int ld, c0, mode = 0;
        if (pn < 4) { base = QA; ld = 1024; c0 = pn * 256; }
        else if (pn == 4) { base = KVA; ld = 256; c0 = 0; }
        else if (pn < 9) { base = QR; ld = 1024; c0 = (pn - 5) * 256; mode = 1; }
        else if (pn < 13) { base = KR; ld = 1024; c0 = (pn - 9) * 256; mode = 2; }
        else if (pn < 21) { base = VR; ld = 2048; c0 = (pn - 13) * 256; }
        else { base = GR; ld = 2048; c0 = (pn - 21) * 256; mode = 3; }
        const int row0 = u.pm * 256 + wr * 64 + fr, cl = c0 + wc * 32 + 8 * fq;
        if (mode == 1 || mode == 2) {
            const float sc = (mode == 2) ? 0.0625f : 1.f;
            float th[2][4];
#pragma unroll
            for (int bj = 0; bj < 2; ++bj)
#pragma unroll
                for (int pp = 0; pp < 4; ++pp) { const int pi = 64 * bj + 16 * wc + 4 * fq + pp; th[bj][pp] = fexp2(-(float)pi * (13.287712379549449f / 127.0f)) * 0.15915494309189535f; }
#pragma unroll
            for (int ai = 0; ai < 2; ++ai)
#pragma unroll
                for (int m = 0; m < 4; ++m) { const int row = row0 + ai * 128 + m * 16; const float pos = (float)(row & (SEQ - 1));
#pragma unroll
                    for (int bj = 0; bj < 2; ++bj) { const f32x4 v0 = acc[ai][bj][m][0], v1 = acc[ai][bj][m][1];
                        const float x[8] = {v0[0], v0[1], v0[2], v0[3], v1[0], v1[1], v1[2], v1[3]}; float o[8];
#pragma unroll
                        for (int pp = 0; pp < 4; ++pp) { const float hi = pos * th[bj][pp], lo = __builtin_fmaf(pos, th[bj][pp], -hi); const float rv = __builtin_amdgcn_fractf(hi) + lo;
                            const float s = __builtin_amdgcn_sinf(rv), c = __builtin_amdgcn_cosf(rv);
                            o[2 * pp] = (x[2 * pp] * c - x[2 * pp + 1] * s) * sc; o[2 * pp + 1] = (x[2 * pp + 1] * c + x[2 * pp] * s) * sc; }
                        st8bf(base + (size_t)row * ld + cl + bj * 128, o); } }
        } else {
#pragma unroll
            for (int ai = 0; ai < 2; ++ai)
#pragma unroll
                for (int m = 0; m < 4; ++m) { const int row = row0 + ai * 128 + m * 16;
#pragma unroll
                    for (int bj = 0; bj < 2; ++bj) { const f32x4 v0 = acc[ai][bj][m][0], v1 = acc[ai][bj][m][1];
                        float o[8] = {v0[0], v0[1], v0[2], v0[3], v1[0], v1[1], v1[2], v1[3]};
                        if (mode == 3) {
#pragma unroll
                            for (int e = 0; e < 8; ++e) o[e] = siluf_(o[e]); }
                        st8bf(base + (size_t)row * ld + cl + bj * 128, o); } }
        }
    }
};
template <int ACT> struct EpiBf {
    bf16_t* O; int ld;
    __device__ __forceinline__ void operator()(AccRef acc, const Unit& u, int wr, int wc, int fr, int fq) const {
        const int row0 = u.pm * 256 + wr * 64 + fr, cl = u.pn * 256 + wc * 32 + 8 * fq;
#pragma unroll
        for (int ai = 0; ai < 2; ++ai)
#pragma unroll
            for (int m = 0; m < 4; ++m) { const int row = row0 + ai * 128 + m * 16;
#pragma unroll
                for (int bj = 0; bj < 2; ++bj) { const f32x4 v0 = acc[ai][bj][m][0], v1 = acc[ai][bj][m][1];
                    float o[8] = {v0[0], v0[1], v0[2], v0[3], v1[0], v1[1], v1[2], v1[3]};
                    if (ACT == 1) {
#pragma unroll
                        for (int e = 0; e < 8; ++e) o[e] = sigmoidf_(o[e]); }
                    st8bf(O + (size_t)row * ld + cl + bj * 128, o); } }
    }
};
struct EpiMerge {
    const bf16_t* __restrict__ SZ; bf16_t* BA;
    __device__ __forceinline__ void operator()(AccRef acc, const Unit& u, int wr, int wc, int fr, int fq) const {
        const int row0 = u.pm * 256 + wr * 64 + fr, cl = u.pn * 256 + wc * 32 + 8 * fq;
#pragma unroll
        for (int ai = 0; ai < 2; ++ai)
#pragma unroll
            for (int mp = 0; mp < 2; ++mp) { u32x4 wa[2][2], wr_[2][2], wb[2][2];
#pragma unroll
                for (int mm = 0; mm < 2; ++mm)
#pragma unroll
                    for (int bj = 0; bj < 2; ++bj) { const size_t row = (size_t)(row0 + ai * 128 + (2 * mp + mm) * 16); const int c = cl + bj * 128;
                        wa[mm][bj] = *(const u32x4*)(SZ + row * 2048 + c); wr_[mm][bj] = *(const u32x4*)(SZ + row * 2048 + 1024 + c); wb[mm][bj] = *(const u32x4*)(BA + row * 1024 + c); }
#pragma unroll
                for (int mm = 0; mm < 2; ++mm)
#pragma unroll
                    for (int bj = 0; bj < 2; ++bj) { const int m = 2 * mp + mm; const size_t row = (size_t)(row0 + ai * 128 + m * 16); const int c = cl + bj * 128;
                        const f32x4 v0 = acc[ai][bj][m][0], v1 = acc[ai][bj][m][1]; const u32x4 A_ = wa[mm][bj], R_ = wr_[mm][bj], B_ = wb[mm][bj];
                        u32x4 o;
                        o.x = pkbf(bflo(A_.x) * bflo(B_.x) + bflo(R_.x) * v0[0], bfhi(A_.x) * bfhi(B_.x) + bfhi(R_.x) * v0[1]);
                        o.y = pkbf(bflo(A_.y) * bflo(B_.y) + bflo(R_.y) * v0[2], bfhi(A_.y) * bfhi(B_.y) + bfhi(R_.y) * v0[3]);
                        o.z = pkbf(bflo(A_.z) * bflo(B_.z) + bflo(R_.z) * v1[0], bfhi(A_.z) * bfhi(B_.z) + bfhi(R_.z) * v1[1]);
                        o.w = pkbf(bflo(A_.w) * bflo(B_.w) + bflo(R_.w) * v1[2], bfhi(A_.w) * bfhi(B_.w) + bfhi(R_.w) * v1[3]);
                        *(u32x4*)(BA + row * 1024 + c) = o; } }
    }
};
struct EpiOut {
    const float* __restrict__ X; bf16_t* __restrict__ X1; float* __restrict__ SS2;
    __device__ __forceinline__ void operator()(AccRef acc, const Unit& u, int wr, int wc, int fr, int fq) const {
        const int row0 = u.pm * 256 + wr * 64 + fr, cl = u.pn * 256 + wc * 32 + 8 * fq;
#pragma unroll
        for (int ai = 0; ai < 2; ++ai) { f32x4 xv[4][2][2];
#pragma unroll
            for (int m = 0; m < 4; ++m)
#pragma unroll
                for (int bj = 0; bj < 2; ++bj) { const size_t off = (size_t)(row0 + ai * 128 + m * 16) * 1024 + cl + bj * 128; xv[m][bj][0] = *(const f32x4*)(X + off); xv[m][bj][1] = *(const f32x4*)(X + off + 4); }
#pragma unroll
            for (int m = 0; m < 4; ++m) { const int row = row0 + ai * 128 + m * 16; float ss = 0.f;
#pragma unroll
                for (int bj = 0; bj < 2; ++bj) { const size_t off = (size_t)row * 1024 + cl + bj * 128;
                    const f32x4 a0 = xv[m][bj][0] + acc[ai][bj][m][0], a1 = xv[m][bj][1] + acc[ai][bj][m][1];
                    { const float xo[8] = {a0[0], a0[1], a0[2], a0[3], a1[0], a1[1], a1[2], a1[3]}; st8bf(X1 + off, xo); }
                    ss += (a0[0] * a0[0] + a0[1] * a0[1]) + (a0[2] * a0[2] + a0[3] * a0[3]) + (a1[0] * a1[0] + a1[1] * a1[1]) + (a1[2] * a1[2] + a1[3] * a1[3]); }
                ss += __shfl_xor(ss, 16); ss += __shfl_xor(ss, 32);
                if (fq == 0) atomicAdd(SS2 + row, ss); } }
    }
};
struct EpiGU {
    LAS const float* TAB; bf16_t* H;
    __device__ __forceinline__ void operator()(AccRef acc, const Unit& u, int wr, int wc, int fr, int fq) const {
        const int row0 = u.pm * 256 + wr * 64 + fr, cl = u.pn * 128 + wc * 32 + 8 * fq;
#pragma unroll
        for (int ai = 0; ai < 2; ++ai)
#pragma unroll
            for (int m = 0; m < 4; ++m) { const int row = row0 + ai * 128 + m * 16;
                const float rstd = TAB[ai * 128 + wr * 64 + m * 16 + fr];
                const f32x4 g0 = acc[ai][0][m][0] * rstd, g1 = acc[ai][0][m][1] * rstd, u0 = acc[ai][1][m][0] * rstd, u1 = acc[ai][1][m][1] * rstd;
                const float gv[8] = {g0[0], g0[1], g0[2], g0[3], g1[0], g1[1], g1[2], g1[3]}, uv[8] = {u0[0], u0[1], u0[2], u0[3], u1[0], u1[1], u1[2], u1[3]}; float o[8];
#pragma unroll
                for (int e = 0; e < 8; ++e) o[e] = siluf_(gv[e]) * uv[e];
                st8bf(H + (size_t)row * DFF + cl, o); }
    }
};
struct EpiDown {
    const bf16_t* __restrict__ X1; float* __restrict__ OUT;
    __device__ __forceinline__ void operator()(AccRef acc, const Unit& u, int wr, int wc, int fr, int fq) const {
        const int row0 = u.pm * 256 + wr * 64 + fr, cl = u.pn * 256 + wc * 32 + 8 * fq;
#pragma unroll
        for (int ai = 0; ai < 2; ++ai) { u32x4 xv[4][2];
#pragma unroll
            for (int m = 0; m < 4; ++m)
#pragma unroll
                for (int bj = 0; bj < 2; ++bj) { const size_t off = (size_t)(row0 + ai * 128 + m * 16) * 1024 + cl + bj * 128; xv[m][bj] = *(const u32x4*)(X1 + off); }
#pragma unroll
            for (int m = 0; m < 4; ++m)
#pragma unroll
                for (int bj = 0; bj < 2; ++bj) { const size_t off = (size_t)(row0 + ai * 128 + m * 16) * 1024 + cl + bj * 128; const u32x4 w = xv[m][bj];
                    const f32x4 x0 = {bflo(w.x), bfhi(w.x), bflo(w.y), bfhi(w.y)}, x1 = {bflo(w.z), bfhi(w.z), bflo(w.w), bfhi(w.w)};
                    *(f32x4*)(OUT + off) = x0 + acc[ai][bj][m][0]; *(f32x4*)(OUT + off + 4) = x1 + acc[ai][bj][m][1]; } }
    }
};

__device__ __forceinline__ void transpose_item(const float* W, int ldw, bf16_t* WT, int ldt, int k0, int n0, int drow, LAS float* scr, int lane, const float* ks = nullptr) {
    float wv[32];
#pragma unroll
    for (int i = 0; i < 32; ++i) { const int kk = 2 * i + (lane >> 5); wv[i] = W[(size_t)(k0 + kk) * ldw + n0 + (lane & 31)]; }
#pragma unroll
    for (int i = 0; i < 32; ++i) { const int kk = 2 * i + (lane >> 5); scr[kk * 33 + (lane & 31)] = wv[i]; }
    asm volatile("s_waitcnt lgkmcnt(0)" ::: "memory");
    const int c = lane & 7;
#pragma unroll
    for (int j = 0; j < 4; ++j) { const int n = (lane >> 3) + 8 * j; const LAS float* s = scr + (8 * c) * 33 + n;
        f32x4 k0v = {1.f, 1.f, 1.f, 1.f}, k1v = {1.f, 1.f, 1.f, 1.f};
        if (ks) { k0v = *(const f32x4*)(ks + k0 + 8 * c); k1v = *(const f32x4*)(ks + k0 + 8 * c + 4); }
        u32x4 o; o.x = pkbf(s[0 * 33] * k0v[0], s[1 * 33] * k0v[1]); o.y = pkbf(s[2 * 33] * k0v[2], s[3 * 33] * k0v[3]); o.z = pkbf(s[4 * 33] * k1v[0], s[5 * 33] * k1v[1]); o.w = pkbf(s[6 * 33] * k1v[2], s[7 * 33] * k1v[3]);
        *(u32x4*)(WT + (size_t)(drow + n) * ldt + k0 + 8 * c) = o; }
    asm volatile("s_waitcnt lgkmcnt(0)" ::: "memory");
}

__device__ __forceinline__ void attn_load(const bf16_t* KVA, int b, int n, int kh, int tid, u32x4 (&kvr)[4], u32x4 (&vvr)[4]) {
    const long tokband = (long)b * SEQ + 128 * (n - 1);
#pragma unroll
    for (int it = 0; it < 4; ++it) { const int id = tid + 512 * it, s = id >> 3, part = id & 7; const bool valid = (n > 0) || (s >= 128);
        kvr[it] = (u32x4){0u, 0u, 0u, 0u}; vvr[it] = (u32x4){0u, 0u, 0u, 0u};
        if (valid) { const bf16_t* src = KVA + (size_t)(tokband + s) * 256 + kh * 64 + part * 8; kvr[it] = *(const u32x4*)src; vvr[it] = *(const u32x4*)(src + 128); } }
}
__device__ __forceinline__ void attn_unit(LAS unsigned char* lds, bf16_t* QA, const bf16_t* KVA, const float* qg, const float* kg, const float* sinks, int b, int n, int kh, int tid, u32x4 (&kvr)[4], u32x4 (&vvr)[4], int un) {
    const int lane = tid & 63, w = __builtin_amdgcn_readfirstlane(tid >> 6), g = lane >> 4, li = lane & 15, q4 = li >> 2, p4 = li & 3;
    LAS unsigned char* Kb = lds; LAS unsigned char* Vb = lds + 256 * 144;
#pragma unroll
    for (int it = 0; it < 4; ++it) { const int id = tid + 512 * it, s = id >> 3, part = id & 7;
        const u32x4 kv = kvr[it], vv = vvr[it];
        float f[8] = {bflo(kv.x), bfhi(kv.x), bflo(kv.y), bfhi(kv.y), bflo(kv.z), bfhi(kv.z), bflo(kv.w), bfhi(kv.w)};
        float ss = 0.f;
#pragma unroll
        for (int e = 0; e < 8; ++e) ss += f[e] * f[e];
        ss += __shfl_xor(ss, 1); ss += __shfl_xor(ss, 2); ss += __shfl_xor(ss, 4);
        const float rstd = 1.0f / sqrtf(ss * (1.0f / 64.0f) + EPS);
        const f32x4 g0 = *(const f32x4*)(kg + part * 8), g1 = *(const f32x4*)(kg + part * 8 + 4);
        u32x4 ko; ko.x = pkbf(f[0] * rstd * g0[0], f[1] * rstd * g0[1]); ko.y = pkbf(f[2] * rstd * g0[2], f[3] * rstd * g0[3]);
        ko.z = pkbf(f[4] * rstd * g1[0], f[5] * rstd * g1[1]); ko.w = pkbf(f[6] * rstd * g1[2], f[7] * rstd * g1[3]);
        *(LAS u32x4*)(Kb + s * 144 + part * 16) = ko; *(LAS u32x4*)(Vb + s * 144 + part * 16) = vv; }
    __syncthreads();
    if (un < 1024) attn_load(KVA, un >> 7, (un >> 1) & 63, un & 1, tid, kvr, vvr);
    const int head = kh * 8 + w; const float sink2 = sinks[head] * LOG2E;
    f32x4 qga[2][2];
#pragma unroll
    for (int kk = 0; kk < 2; ++kk) { qga[kk][0] = *(const f32x4*)(qg + 32 * kk + 8 * g); qga[kk][1] = *(const f32x4*)(qg + 32 * kk + 8 * g + 4); }
    bf16_t* const qp0 = QA + ((size_t)b * SEQ + 128 * n + li) * 1024 + head * 64 + 8 * g;
    u32x4 q0n = *(const u32x4*)qp0, q1n = *(const u32x4*)(qp0 + 32);
    for (int sb = 0; sb < 8; ++sb) {
        const int i = 16 * sb + li; const size_t tok = (size_t)b * SEQ + 128 * n + i;
        const u32x4 q0 = q0n, q1 = q1n;
        if (sb + 1 < 8) { q0n = *(const u32x4*)(qp0 + (size_t)(sb + 1) * 16 * 1024); q1n = *(const u32x4*)(qp0 + (size_t)(sb + 1) * 16 * 1024 + 32); }
        float f0[8] = {bflo(q0.x), bfhi(q0.x), bflo(q0.y), bfhi(q0.y), bflo(q0.z), bfhi(q0.z), bflo(q0.w), bfhi(q0.w)};
        float f1[8] = {bflo(q1.x), bfhi(q1.x), bflo(q1.y), bfhi(q1.y), bflo(q1.z), bfhi(q1.z), bflo(q1.w), bfhi(q1.w)};
        float ss = 0.f;
#pragma unroll
        for (int e = 0; e < 8; ++e) ss += f0[e] * f0[e] + f1[e] * f1[e];
        ss += __shfl_xor(ss, 16); ss += __shfl_xor(ss, 32);
        const float qs = (1.0f / sqrtf(ss * (1.0f / 64.0f) + EPS)) * (0.125f * LOG2E);
        bf16x8 Qf[2];
        { u32x4 t; t.x = pkbf(f0[0] * qs * qga[0][0][0], f0[1] * qs * qga[0][0][1]); t.y = pkbf(f0[2] * qs * qga[0][0][2], f0[3] * qs * qga[0][0][3]);
          t.z = pkbf(f0[4] * qs * qga[0][1][0], f0[5] * qs * qga[0][1][1]); t.w = pkbf(f0[6] * qs * qga[0][1][2], f0[7] * qs * qga[0][1][3]); Qf[0] = __builtin_bit_cast(bf16x8, t); }
        { u32x4 t; t.x = pkbf(f1[0] * qs * qga[1][0][0], f1[1] * qs * qga[1][0][1]); t.y = pkbf(f1[2] * qs * qga[1][0][2], f1[3] * qs * qga[1][0][3]);
          t.z = pkbf(f1[4] * qs * qga[1][1][0], f1[5] * qs * qga[1][1][1]); t.w = pkbf(f1[6] * qs * qga[1][1][2], f1[7] * qs * qga[1][1][3]); Qf[1] = __builtin_bit_cast(bf16x8, t); }
        f32x4 sc[9];
#pragma unroll
        for (int tt = 0; tt < 9; ++tt) { LAS unsigned char* kp = Kb + (16 * (sb + tt) + li) * 144 + 16 * g;
            f32x4 a_ = (f32x4){0.f, 0.f, 0.f, 0.f}; a_ = mfma16(ldsrow(kp), Qf[0], a_); a_ = mfma16(ldsrow(kp + 64), Qf[1], a_); sc[tt] = a_; }
#pragma unroll
        for (int jj = 0; jj < 4; ++jj) { if (4 * g + jj <= li) sc[0][jj] = -INFINITY; if (4 * g + jj > li) sc[8][jj] = -INFINITY; }
        if (n == 0) {
#pragma unroll
            for (int tt = 0; tt < 8; ++tt) if (sb + tt < 8) sc[tt] = (f32x4){-INFINITY, -INFINITY, -INFINITY, -INFINITY}; }
        float mx = sink2;
#pragma unroll
        for (int tt = 0; tt < 9; ++tt) mx = fmaxf(fmaxf(mx, fmaxf(sc[tt][0], sc[tt][1])), fmaxf(sc[tt][2], sc[tt][3]));
        mx = fmaxf(mx, __shfl_xor(mx, 16)); mx = fmaxf(mx, __shfl_xor(mx, 32));
        float l = 0.f;
#pragma unroll
        for (int tt = 0; tt < 9; ++tt)
#pragma unroll
            for (int jj = 0; jj < 4; ++jj) { const float p = fexp2(sc[tt][jj] - mx); sc[tt][jj] = p; l += p; }
        l += __shfl_xor(l, 16); l += __shfl_xor(l, 32); l += fexp2(sink2 - mx);
        const float inv = 1.0f / l;
        bf16x8 Pb[5];
#pragma unroll
        for (int k2 = 0; k2 < 4; ++k2) { u32x4 t; t.x = pkbf(sc[2 * k2][0], sc[2 * k2][1]); t.y = pkbf(sc[2 * k2][2], sc[2 * k2][3]); t.z = pkbf(sc[2 * k2 + 1][0], sc[2 * k2 + 1][1]); t.w = pkbf(sc[2 * k2 + 1][2], sc[2 * k2 + 1][3]); Pb[k2] = __builtin_bit_cast(bf16x8, t); }
        { u32x4 t; t.x = pkbf(sc[8][0], sc[8][1]); t.y = pkbf(sc[8][2], sc[8][3]); t.z = 0u; t.w = 0u; Pb[4] = __builtin_bit_cast(bf16x8, t); }
#pragma unroll
        for (int dt = 0; dt < 4; ++dt) { f32x4 o = (f32x4){0.f, 0.f, 0.f, 0.f};
#pragma unroll
            for (int k2 = 0; k2 < 4; ++k2) { LAS unsigned char* vp = Vb + (16 * (sb + 2 * k2) + 4 * g + q4) * 144 + (16 * dt + 4 * p4) * 2;
                o = mfma16(cat8(ldstr(vp), ldstr(vp + 16 * 144)), Pb[k2], o); }
            { LAS unsigned char* vp = Vb + (16 * (sb + 8) + 4 * g + q4) * 144 + (16 * dt + 4 * p4) * 2;
              o = mfma16(cat8(ldstr(vp), (s16x4){0, 0, 0, 0}), Pb[4], o); }
            u32x2 wv; wv.x = pkbf(o[0] * inv, o[1] * inv); wv.y = pkbf(o[2] * inv, o[3] * inv);
            *(u32x2*)(QA + tok * 1024 + head * 64 + 16 * dt + 4 * g) = wv; }
    }
    __syncthreads();
}

constexpr int RK_STRIDE = 528, RV_STRIDE = 144, R_KOFF = 0, R_VOFF = 128 * RK_STRIDE, R_SOFF = R_VOFF + 128 * RV_STRIDE;
__device__ __forceinline__ void ret_unit(LAS unsigned char* lds, const bf16_t* QR, const bf16_t* KR, bf16_t* VR, const bf16_t* GR, float* SS, int b, int h, int vs, int tid) {
    const int lane = tid & 63, w = __builtin_amdgcn_readfirstlane(tid >> 6), g = lane >> 4, li = lane & 15, q4 = li >> 2, p4 = li & 3;
    LAS unsigned char* Kl = lds + R_KOFF; LAS unsigned char* Vl = lds + R_VOFF; LAS unsigned char* Sl0 = lds + R_SOFF;
    const float lg = log2f(1.0f - exp2f(-5.0f - (float)h));
    const int rb = w < 4 ? w : 11 - w;
    const int irow = 16 * rb + li;
    const float rho = fexp2((float)(irow - 127) * lg), xi = fexp2((float)(irow + 1) * lg), g128 = fexp2(128.0f * lg);
    const float zeta0 = fexp2((float)(127 - (tid >> 3)) * lg), zeta1 = fexp2((float)(127 - 64 - (tid >> 3)) * lg);
    for (int id = tid; id < 64 * RK_STRIDE / 16; id += 512) *(LAS u32x4*)(Sl0 + id * 16) = (u32x4){0u, 0u, 0u, 0u};
    f32x4 S[2][4];
#pragma unroll
    for (int a = 0; a < 2; ++a)
#pragma unroll
        for (int v = 0; v < 4; ++v) S[a][v] = (f32x4){0.f, 0.f, 0.f, 0.f};
    u32x4 kreg[8], vreg[2]; u32x2 greg[4]; bf16x8 Qf[8], Qn[8];
    const unsigned koff = (unsigned)(((tid >> 5) * 1024 + (tid & 31) * 8) * 2), voff = (unsigned)(((tid >> 3) * 2048 + (tid & 7) * 8) * 2);
    const unsigned qoff = (unsigned)((irow * 1024 + 8 * g) * 2), goff = (unsigned)((irow * 2048 + 4 * g) * 2);
    const char* const kbase0 = (const char*)KR + ((size_t)b * SEQ * 1024 + h * 256) * 2; const char* const qbase0 = (const char*)QR + ((size_t)b * SEQ * 1024 + h * 256) * 2;
    char* const vbase0 = (char*)VR + ((size_t)b * SEQ * 2048 + h * 512 + vs * 64) * 2; const char* const gbase0 = (const char*)GR + ((size_t)b * SEQ * 2048 + h * 512 + vs * 64) * 2;
#define RET_LOAD_KV(cc) do { const char* kb_ = kbase0 + (size_t)(cc) * (128 * 1024 * 2); const char* vb_ = vbase0 + (size_t)(cc) * (128 * 2048 * 2); \
        _Pragma("unroll") for (int it = 0; it < 8; ++it) kreg[it] = *(const u32x4*)(kb_ + it * (16 * 1024 * 2) + koff); \
        _Pragma("unroll") for (int it = 0; it < 2; ++it) vreg[it] = *(const u32x4*)(vb_ + it * (64 * 2048 * 2) + voff); } while (0)
#define RET_LOAD_G(cc) do { const char* gb_ = gbase0 + (size_t)(cc) * (128 * 2048 * 2); \
        _Pragma("unroll") for (int vt = 0; vt < 4; ++vt) greg[vt] = *(const u32x2*)(gb_ + vt * 32 + goff); } while (0)
#define RET_LOAD_Q(cc) do { const char* qb_ = qbase0 + (size_t)(cc) * (128 * 1024 * 2); \
        _Pragma("unroll") for (int kk = 0; kk < 8; ++kk) Qn[kk] = *(const bf16x8*)(qb_ + kk * 64 + qoff); } while (0)
    RET_LOAD_KV(0); RET_LOAD_Q(0); RET_LOAD_G(0);
    for (int c = 0; c < 64; ++c) {
        const size_t tok0 = (size_t)b * SEQ + 128 * c;
        LAS unsigned char* Sl = Sl0 + (c & 1) * (64 * RK_STRIDE); LAS unsigned char* Sw = Sl0 + ((c + 1) & 1) * (64 * RK_STRIDE);
        __syncthreads();
#pragma unroll
        for (int it = 0; it < 8; ++it) { const int id = tid + 512 * it, row = id >> 5, part = id & 31; *(LAS u32x4*)(Kl + row * RK_STRIDE + part * 16) = kreg[it]; }
#pragma unroll
        for (int it = 0; it < 2; ++it) { const int id = tid + 512 * it, row = id >> 3, part = id & 7; const float z = it ? zeta1 : zeta0; const u32x4 v = vreg[it];
            u32x4 o; o.x = pkbf(bflo(v.x) * z, bfhi(v.x) * z); o.y = pkbf(bflo(v.y) * z, bfhi(v.y) * z); o.z = pkbf(bflo(v.z) * z, bfhi(v.z) * z); o.w = pkbf(bflo(v.w) * z, bfhi(v.w) * z);
            *(LAS u32x4*)(Vl + row * RV_STRIDE + part * 16) = o; }
#pragma unroll
        for (int kk = 0; kk < 8; ++kk) Qf[kk] = Qn[kk];
        __syncthreads();
        if (c + 1 < 64) RET_LOAD_KV(c + 1);
        f32x4 P[8];
#pragma unroll
        for (int t = 0; t < 8; ++t) { P[t] = (f32x4){0.f, 0.f, 0.f, 0.f};
            if (t <= rb) { LAS unsigned char* kp = Kl + (16 * t + li) * RK_STRIDE + 16 * g;
#pragma unroll
                for (int kk = 0; kk < 8; ++kk) P[t] = mfma16(ldsrow(kp + 64 * kk), Qf[kk], P[t]);
                if (t == rb) {
#pragma unroll
                    for (int jj = 0; jj < 4; ++jj) if (4 * g + jj > li) P[t][jj] = 0.f; } } }
        if (c + 1 < 64) RET_LOAD_Q(c + 1);
        bf16x8 Pb[4];
#pragma unroll
        for (int k2 = 0; k2 < 4; ++k2) { u32x4 t; t.x = pkbf(P[2 * k2][0], P[2 * k2][1]); t.y = pkbf(P[2 * k2][2], P[2 * k2][3]); t.z = pkbf(P[2 * k2 + 1][0], P[2 * k2 + 1][1]); t.w = pkbf(P[2 * k2 + 1][2], P[2 * k2 + 1][3]); Pb[k2] = __builtin_bit_cast(bf16x8, t); }
        float ssq = 0.f;
#pragma unroll
        for (int vt = 0; vt < 4; ++vt) { f32x4 a1 = (f32x4){0.f, 0.f, 0.f, 0.f}, a2 = (f32x4){0.f, 0.f, 0.f, 0.f};
#pragma unroll
            for (int k2 = 0; k2 < 4; ++k2) if (2 * k2 <= rb) { LAS unsigned char* vp = Vl + (32 * k2 + 4 * g + q4) * RV_STRIDE + (16 * vt + 4 * p4) * 2;
                a1 = mfma16(cat8(ldstr(vp), ldstr(vp + 16 * RV_STRIDE)), Pb[k2], a1); }
            LAS unsigned char* sp = Sl + (16 * vt + li) * RK_STRIDE + 16 * g;
#pragma unroll
            for (int kk = 0; kk < 8; ++kk) a2 = mfma16(ldsrow(sp + 64 * kk), Qf[kk], a2);
            const f32x4 o = a1 * rho + a2 * xi;
            ssq += (o[0] * o[0] + o[1] * o[1]) + (o[2] * o[2] + o[3] * o[3]);
            const u32x2 gq = greg[vt];
            u32x2 wv; wv.x = pkbf(o[0] * bflo(gq.x), o[1] * bfhi(gq.x)); wv.y = pkbf(o[2] * bflo(gq.y), o[3] * bfhi(gq.y));
            *(u32x2*)(vbase0 + (size_t)c * (128 * 2048 * 2) + vt * 32 + goff) = wv; }
        if (c + 1 < 64) RET_LOAD_G(c + 1);
        ssq += __shfl_xor(ssq, 16); ssq += __shfl_xor(ssq, 32);
        if (g == 0) atomicAdd(SS + (tok0 + irow) * 4 + h, ssq);
#pragma unroll
        for (int a = 0; a < 2; ++a)
#pragma unroll
            for (int v = 0; v < 4; ++v) S[a][v] = S[a][v] * g128;
#pragma unroll
        for (int kk = 0; kk < 4; ++kk) { bf16x8 Af[2], Bf[4];
#pragma unroll
            for (int a = 0; a < 2; ++a) { LAS unsigned char* kp = Kl + (32 * kk + 8 * g + q4) * RK_STRIDE + (16 * (2 * w + a) + 4 * p4) * 2; Af[a] = cat8(ldstr(kp), ldstr(kp + 4 * RK_STRIDE)); }
#pragma unroll
            for (int v = 0; v < 4; ++v) { LAS unsigned char* vp = Vl + (32 * kk + 8 * g + q4) * RV_STRIDE + (16 * v + 4 * p4) * 2; Bf[v] = cat8(ldstr(vp), ldstr(vp + 4 * RV_STRIDE)); }
#pragma unroll
            for (int a = 0; a < 2; ++a)
#pragma unroll
                for (int v = 0; v < 4; ++v) S[a][v] = mfma16(Af[a], Bf[v], S[a][v]); }
#pragma unroll
        for (int a = 0; a < 2; ++a)
#pragma unroll
            for (int v = 0; v < 4; ++v) { u32x2 wv; wv.x = pkbf(S[a][v][0], S[a][v][1]); wv.y = pkbf(S[a][v][2], S[a][v][3]);
                *(LAS u32x2*)(Sw + (16 * v + li) * RK_STRIDE + (16 * (2 * w + a) + 4 * g) * 2) = wv; }
    }
    __syncthreads();
}

constexpr int BAR_STRIDE = 64;
__device__ __forceinline__ void grid_bar(unsigned* bar, unsigned k, unsigned G) {
    asm volatile("s_waitcnt vmcnt(0)" ::: "memory");
    __syncthreads();
    if (threadIdx.x == 0) {
        const unsigned grp = blockIdx.x & 7u, ngrp = G < 8u ? G : 8u, nloc = (G - grp + 7u) >> 3;
        unsigned* gcnt = bar + grp * BAR_STRIDE; unsigned* gflag = bar + (8 + grp) * BAR_STRIDE; unsigned* top = bar + 16 * BAR_STRIDE;
        __builtin_amdgcn_fence(__ATOMIC_RELEASE, "agent");
        asm volatile("s_waitcnt vmcnt(0)" ::: "memory");
        const unsigned old = __hip_atomic_fetch_add(gcnt, 1u, __ATOMIC_RELAXED, __HIP_MEMORY_SCOPE_AGENT);
        if (old + 1u == k * nloc) {
            __hip_atomic_fetch_add(top, 1u, __ATOMIC_RELAXED, __HIP_MEMORY_SCOPE_AGENT);
            while (__hip_atomic_load(top, __ATOMIC_RELAXED, __HIP_MEMORY_SCOPE_AGENT) < k * ngrp) __builtin_amdgcn_s_sleep(1);
            __hip_atomic_store(gflag, k, __ATOMIC_RELAXED, __HIP_MEMORY_SCOPE_AGENT);
        } else {
            while (__hip_atomic_load(gflag, __ATOMIC_RELAXED, __HIP_MEMORY_SCOPE_AGENT) < k) __builtin_amdgcn_s_sleep(1);
        }
        __builtin_amdgcn_fence(__ATOMIC_ACQUIRE, "agent");
        asm volatile("s_waitcnt vmcnt(0)" ::: "memory");
    }
    __syncthreads();
}
struct Args { const float* in[13]; float* out; unsigned char* ws; int ph_lo, ph_hi, coop, pad; };

__global__ void __launch_bounds__(512, 2) fwd_kernel(Args a) {
    extern __shared__ __attribute__((aligned(16))) unsigned char lds_raw[];
    LAS unsigned char* lds = (LAS unsigned char*)lds_raw;
    cg::grid_group grid = cg::this_grid();
    const int tid = threadIdx.x, lane = tid & 63, wave = __builtin_amdgcn_readfirstlane(tid >> 6);
    const int G = gridDim.x, bid = blockIdx.x;
    const int gw = bid * 8 + wave, NGW = G * 8;
    unsigned char* ws = a.ws;
    const float* x = a.in[0];
    bf16_t* QA = (bf16_t*)(ws + WS_QA); bf16_t* KVA = (bf16_t*)(ws + WS_KVA); bf16_t* QR = (bf16_t*)(ws + WS_QR); bf16_t* KR = (bf16_t*)(ws + WS_KR);
    bf16_t* VR = (bf16_t*)(ws + WS_VR); bf16_t* GR = (bf16_t*)(ws + WS_GR);
    bf16_t* WIN = (bf16_t*)(ws + WS_WIN); bf16_t* WBA = (bf16_t*)(ws + WS_WBA); bf16_t* WBR = (bf16_t*)(ws + WS_WBR); bf16_t* WOUT = (bf16_t*)(ws + WS_WOUT);
    bf16_t* WGU = (bf16_t*)(ws + WS_WGU); bf16_t* WD = (bf16_t*)(ws + WS_WD);
    float* SS = (float*)(ws + WS_SS); float* SS2 = (float*)(ws + WS_SS2);
    bf16_t* SZ = (bf16_t*)(ws + WS_SZ); bf16_t* X1 = (bf16_t*)(ws + WS_X1); bf16_t* XN2 = (bf16_t*)(ws + WS_XN2); bf16_t* H = (bf16_t*)(ws + WS_H);
    bf16_t* XN = (bf16_t*)((unsigned char*)a.out + OUT_XN); bf16_t* BA = (bf16_t*)((unsigned char*)a.out + OUT_BA);
    const int lo = a.ph_lo, hi = a.ph_hi;
#define IN(k) (lo <= (k) && (k) < hi)
#ifdef PROBE_DELAY
    unsigned long long tmark = __builtin_amdgcn_s_memrealtime();
#define STAMP(i) do { if ((PROBE_DELAY >> (i)) & 1) { const unsigned long long tb_ = __builtin_amdgcn_s_memrealtime(), d_ = tb_ - tmark; \
        while (__builtin_amdgcn_s_memrealtime() - tb_ < d_) __builtin_amdgcn_s_sleep(8); } tmark = __builtin_amdgcn_s_memrealtime(); } while (0)
#else
#define STAMP(i) do { } while (0)
#endif
    unsigned* const barcnt = (unsigned*)(ws + WS_END);
#define SEAM(k) do { if (a.coop && IN(k) && IN((k) + 1)) { if ((k) == 0) grid.sync(); else grid_bar(barcnt, (unsigned)(k), (unsigned)G); } } while (0)

    if (IN(0)) {
        LAS float* scr = (LAS float*)(lds + wave * 16384);
        constexpr int I_IN = 16 * (DIN / 32), I_BA = 16 * 32, I_BR = 32 * 32, I_OUT = 16 * 32, I_G = 16 * (DFF / 32), I_D = (DFF / 64) * 32;
        constexpr int NITEMS = I_IN + I_BA + I_BR + I_OUT + 2 * I_G + I_D;
        for (int it = gw; it < NITEMS; it += NGW) {
            int r = it;
            if (r < I_IN) { const int nb = DIN / 32, kb = r / nb, n0 = 32 * (r % nb); transpose_item(a.in[2], DIN, WIN, 1024, 64 * kb, n0, n0, scr, lane); continue; } r -= I_IN;
            if (r < I_BA) { const int kb = r / 32, n0 = 32 * (r % 32); transpose_item(a.in[6], 1024, WBA, 1024, 64 * kb, n0, n0, scr, lane); continue; } r -= I_BA;
            if (r < I_BR) { const int kb = r / 32, n0 = 32 * (r % 32); transpose_item(a.in[7], 1024, WBR, 2048, 64 * kb, n0, n0, scr, lane); continue; } r -= I_BR;
            if (r < I_OUT) { const int kb = r / 32, n0 = 32 * (r % 32); transpose_item(a.in[8], 1024, WOUT, 1024, 64 * kb, n0, n0, scr, lane); continue; } r -= I_OUT;
            if (r < I_G) { const int nb = DFF / 32, kb = r / nb, n0 = 32 * (r % nb); transpose_item(a.in[10], DFF, WGU, 1024, 64 * kb, n0, 256 * (n0 >> 7) + (n0 & 127), scr, lane, a.in[9]); continue; } r -= I_G;
            if (r < I_G) { const int nb = DFF / 32, kb = r / nb, n0 = 32 * (r % nb); transpose_item(a.in[11], DFF, WGU, 1024, 64 * kb, n0, 256 * (n0 >> 7) + 128 + (n0 & 127), scr, lane, a.in[9]); continue; } r -= I_G;
            { const int kb = r / 32, n0 = 32 * (r % 32); transpose_item(a.in[12], 1024, WD, DFF, 64 * kb, n0, n0, scr, lane); }
        }
        const float* g1 = a.in[1];
        f32x4 gv[4];
#pragma unroll
        for (int j = 0; j < 4; ++j) gv[j] = *(const f32x4*)(g1 + 4 * lane + 256 * j);
        f32x4 vn[4];
        { const f32x4* xr = (const f32x4*)(x + (size_t)gw * DM) + lane;
#pragma unroll
          for (int j = 0; j < 4; ++j) vn[j] = xr[64 * j]; }
        for (int m = gw; m < M_TOK; m += NGW) {
            f32x4 v[4]; float s = 0.f;
#pragma unroll
            for (int j = 0; j < 4; ++j) v[j] = vn[j];
            if (m + NGW < M_TOK) { const f32x4* xr = (const f32x4*)(x + (size_t)(m + NGW) * DM) + lane;
#pragma unroll
                for (int j = 0; j < 4; ++j) vn[j] = xr[64 * j]; }
#pragma unroll
            for (int j = 0; j < 4; ++j) s += (v[j][0] * v[j][0] + v[j][1] * v[j][1]) + (v[j][2] * v[j][2] + v[j][3] * v[j][3]);
            const float rstd = 1.0f / sqrtf(wave_sum(s) * (1.0f / DM) + EPS);
            u32x2* o8 = (u32x2*)(XN + (size_t)m * DM) + lane;
#pragma unroll
            for (int j = 0; j < 4; ++j) { const f32x4 t = v[j] * rstd * gv[j]; u32x2 wv; wv.x = pkbf(t[0], t[1]); wv.y = pkbf(t[2], t[3]); o8[64 * j] = wv; }
        }
        for (int i = bid * 512 + tid; i < M_TOK * 4 / 4; i += G * 512) ((f32x4*)SS)[i] = (f32x4){0.f, 0.f, 0.f, 0.f};
        for (int i = bid * 512 + tid; i < M_TOK / 4; i += G * 512) ((f32x4*)SS2)[i] = (f32x4){0.f, 0.f, 0.f, 0.f};
        if (bid == 0 && tid < 17) __hip_atomic_store(barcnt + tid * BAR_STRIDE, 0u, __ATOMIC_RELAXED, __HIP_MEMORY_SCOPE_AGENT);
        __syncthreads();
    }
    SEAM(0); STAMP(1);
    if (IN(1)) {
        pg8::Gemm g{XN, WIN, 1024, 1024, M_TOK, N_IN1, 1024}; pg8::StaticOrder S; S.init(M_TOK, N_IN1, G, bid);
        EpiIn E{QA, KVA, QR, KR, VR, GR};
        pg8::gemm_phase(lds, g, S, E);
    }
    SEAM(1); STAMP(2);
    if (IN(2)) {
        for (int u = bid; u < 256; u += G) { const int xcd = u & 7, idx = u >> 3, bh = xcd * 4 + (idx >> 3), vs = idx & 7; ret_unit(lds, QR, KR, VR, GR, SS, bh >> 2, bh & 3, vs, tid); }
        STAMP(9);
        { u32x4 kvr[4], vvr[4];
          if (bid < 1024) attn_load(KVA, bid >> 7, (bid >> 1) & 63, bid & 1, tid, kvr, vvr);
          for (int u = bid; u < 1024; u += G) attn_unit(lds, QA, KVA, a.in[3], a.in[4], a.in[5], u >> 7, (u >> 1) & 63, u & 1, tid, kvr, vvr, u + G); }
    }
    SEAM(2); STAMP(3);
    if (IN(3)) {
        { pg8::Gemm g{XN, WIN + (size_t)N_IN1 * 1024, 1024, 1024, M_TOK, 2048, 1024}; pg8::StaticOrder S; S.init(M_TOK, 2048, G, bid); EpiBf<1> E{SZ, 2048}; pg8::gemm_phase(lds, g, S, E); }
        { pg8::Gemm g{QA, WBA, 1024, 1024, M_TOK, 1024, 1024}; pg8::StaticOrder S; S.init(M_TOK, 1024, G, bid); EpiBf<0> E{BA, 1024}; pg8::gemm_phase(lds, g, S, E); }
    }
    SEAM(3); STAMP(4);
    if (IN(4)) {
        pg8::Gemm g{VR, WBR, 2048, 2048, M_TOK, 1024, 2048}; pg8::StaticOrder S; S.init(M_TOK, 1024, G, bid, 1); EpiMerge E{SZ, BA}; pg8::gemm_phase<EpiMerge, pg8::StaticOrder, true>(lds, g, S, E, SS);
    }
    SEAM(4); STAMP(5);
    if (IN(5)) {
        pg8::Gemm g{BA, WOUT, 1024, 1024, M_TOK, 1024, 1024}; pg8::StaticOrder S; S.init(M_TOK, 1024, G, bid); EpiOut E{x, X1, SS2}; pg8::gemm_phase(lds, g, S, E);
    }
    SEAM(5); STAMP(6);
    if (IN(6)) {
        pg8::Gemm g{X1, WGU, 1024, 1024, M_TOK, 2 * DFF, 1024}; pg8::StaticOrder S; S.init(M_TOK, 2 * DFF, G, bid, 1); EpiGU E{(LAS const float*)(lds + pg8::STAGE_BYTES), H}; pg8::gemm_phase<EpiGU, pg8::StaticOrder, false, true>(lds, g, S, E, SS2);
    }
    SEAM(6); STAMP(7);
    if (IN(7)) {
        pg8::Gemm g{H, WD, DFF, DFF, M_TOK, 1024, DFF}; pg8::StaticOrder S; S.init(M_TOK, 1024, G, bid); EpiDown E{X1, a.out}; pg8::gemm_phase(lds, g, S, E);
    }
    STAMP(8);
#undef IN
#undef SEAM
}

#ifndef MK_COOP
#define MK_COOP 1
#endif
extern "C" void kernel_launch(void* const* d_in, const int* in_sizes, int n_in, void* d_out, int out_size, void* d_ws, size_t ws_size, hipStream_t stream) {
    static int grid = 0;
    if (grid == 0) {
        if (n_in != 13 || in_sizes[0] != M_TOK * DM || out_size != M_TOK * DM || ws_size < WS_END) { fprintf(stderr, "kernel_launch: unexpected shapes (n_in %d, in0 %d, out %d, ws %zu)\n", n_in, n_in > 0 ? in_sizes[0] : -1, out_size, ws_size); grid = -1; return; }
        int dev = 0, cus = 0, per_cu = 0;
        hipGetDevice(&dev); hipDeviceGetAttribute(&cus, hipDeviceAttributeMultiprocessorCount, dev);
        if (hipFuncSetAttribute((const void*)fwd_kernel, hipFuncAttributeMaxDynamicSharedMemorySize, LDS_BYTES) != hipSuccess) { fprintf(stderr, "kernel_launch: hipFuncSetAttribute failed\n"); grid = -1; return; }
        if (hipOccupancyMaxActiveBlocksPerMultiprocessor(&per_cu, (const void*)fwd_kernel, 512, LDS_BYTES) != hipSuccess || per_cu < 1) { fprintf(stderr, "kernel_launch: occupancy query says %d\n", per_cu); per_cu = 1; }
        (void)hipGetLastError();
        grid = cus * per_cu; if (grid > 256) grid = 256;
        fprintf(stderr, "kernel_launch: grid %d (cus %d, per_cu %d)\n", grid, cus, per_cu);
    }
    if (grid < 0) return;
    Args a{};
    for (int i = 0; i < 13; ++i) a.in[i] = (const float*)d_in[i];
    a.out = (float*)d_out; a.ws = (unsigned char*)d_ws;
#if MK_COOP
    a.ph_lo = 0; a.ph_hi = 8; a.coop = 1; a.pad = 0;
    void* args[] = {&a};
    hipError_t e = hipLaunchCooperativeKernel((const void*)fwd_kernel, dim3(grid), dim3(512), args, LDS_BYTES, stream);
    if (e != hipSuccess) fprintf(stderr, "cooperative launch failed: %s (grid %d)\n", hipGetErrorString(e), grid);
#else
    for (int p = 0; p < 8; ++p) { a.ph_lo = p; a.ph_hi = p + 1; a.coop = 0; a.pad = 0; hipLaunchKernelGGL(fwd_kernel, dim3(grid), dim3(512), LDS_BYTES, stream, a); }
#endif
}
```
